# Optimizing an MI355X kernel written in HIP

```python
import jax, jax.numpy as jnp
from jax import lax
import numpy as np

D_MODEL = 1024
BATCH = 2
SEQ = 8192
DEPTH = 2

CHUNK = 64
EPS = 1e-6
CONV_K = 4
A_HEADS = 8
A_HEAD_DIM = 64
A_LEFT_CHUNKS = 8
A_MAX_REL = 256
B_HEADS = 4
B_HEAD_DIM = 128
C_HEADS = 8
C_HEAD_DIM = 64
C_GROUPS = 2
C_STATE = 128
D_HEADS = 8
D_HEAD_DIM = 64
D_QBLOCK = 128
D_FF = -(-8 * D_MODEL // (3 * 256)) * 256

A_W = A_HEADS * A_HEAD_DIM
B_W = B_HEADS * B_HEAD_DIM
C_W = C_HEADS * C_HEAD_DIM
D_W = D_HEADS * D_HEAD_DIM
C_BC = C_GROUPS * C_STATE
C_CONV_CH = C_W + 2 * C_BC
EVEN_SPLIT = (A_W, A_W, A_W, 3 * B_W, B_HEADS, B_HEADS, B_W)
ODD_SPLIT = (C_W, C_CONV_CH, C_HEADS, D_W, D_W, D_W, D_HEADS)
PROJ_EVEN = sum(EVEN_SPLIT)
PROJ_ODD = sum(ODD_SPLIT)
N_EVEN = (DEPTH + 1) // 2
N_ODD = DEPTH // 2

kernel_name = "hybrid_chunk_causal_encoder_trunk"


def rms_norm(x, w):
    xf = x.astype(jnp.float32)
    y = xf * lax.rsqrt(jnp.mean(xf * xf, axis=-1, keepdims=True) + EPS)
    return (y * w.astype(jnp.float32)).astype(x.dtype)


def l2_normalize(x):
    return x * lax.rsqrt(jnp.sum(x * x, axis=-1, keepdims=True) + EPS)


def split_cols(a, sizes):
    return jnp.split(a, np.cumsum(sizes)[:-1].tolist(), axis=-1)


def causal_depthwise_conv(x, w):
    return lax.conv_general_dilated(
        x, w[:, None, :].astype(x.dtype), window_strides=(1,),
        padding=[(CONV_K - 1, 0)], dimension_numbers=("NWC", "WIO", "NWC"),
        feature_group_count=x.shape[-1])


def swiglu(h, w_gate, w_up, w_down):
    return (jax.nn.silu(h @ w_gate) * (h @ w_up)) @ w_down


def chunk_band_attention(q, k, v, rel_bias):
    bsz, t, h, dh = q.shape
    nc = t // CHUNK
    band = A_LEFT_CHUNKS + 1
    qc = q.reshape(bsz, nc, CHUNK, h, dh)
    pad = ((0, 0), (A_LEFT_CHUNKS, 0), (0, 0), (0, 0), (0, 0))
    kp = jnp.pad(k.reshape(bsz, nc, CHUNK, h, dh), pad)
    vp = jnp.pad(v.reshape(bsz, nc, CHUNK, h, dh), pad)
    kb = jnp.concatenate([kp[:, j:j + nc] for j in range(band)], axis=2)
    vb = jnp.concatenate([vp[:, j:j + nc] for j in range(band)], axis=2)
    qi = jnp.arange(CHUNK)
    kj = jnp.arange(band * CHUNK)
    dist = qi[:, None] + A_LEFT_CHUNKS * CHUNK - kj[None, :]
    idx = jnp.clip(dist, -A_MAX_REL, A_MAX_REL) + A_MAX_REL
    bias = rel_bias.astype(jnp.float32)[:, idx]
    valid = (jnp.arange(nc)[:, None] - A_LEFT_CHUNKS + kj[None, :] // CHUNK) >= 0
    s = jnp.einsum("bnqhd,bnkhd->bnhqk", qc, kb).astype(jnp.float32) * (dh ** -0.5) + bias
    s = jnp.where(valid[None, :, None, None, :], s, -jnp.inf)
    p = jax.nn.softmax(s, axis=-1).astype(v.dtype)
    o = jnp.einsum("bnhqk,bnkhd->bnqhd", p, vb)
    return o.reshape(bsz, t, h * dh)


def gated_delta_rule(q, k, v, beta, g):
    f32 = jnp.float32
    bsz, t, h, dk = q.shape
    dv = v.shape[-1]
    nc = t // CHUNK
    q = l2_normalize(q.astype(f32)) * (dk ** -0.5)
    k = l2_normalize(k.astype(f32))
    v = v.astype(f32)

    def to_chunks(a):
        return jnp.moveaxis(a.astype(f32).reshape((bsz, nc, CHUNK) + a.shape[2:]), 3, 1)

    q, k, v, beta, g = (to_chunks(a) for a in (q, k, v, beta, g))
    gc = jnp.cumsum(g, axis=-1)
    causal = jnp.tril(jnp.ones((CHUNK, CHUNK), bool))
    strict = jnp.tril(jnp.ones((CHUNK, CHUNK), bool), -1)
    decay = jnp.exp(jnp.where(causal, gc[..., :, None] - gc[..., None, :], -jnp.inf))
    kk = jnp.einsum("bhnid,bhnjd->bhnij", k, k)
    a_strict = jnp.where(strict, beta[..., :, None] * kk * decay, 0.0)
    m = a_strict + jnp.eye(CHUNK, dtype=f32)
    rhs = jnp.concatenate([v * beta[..., None], k * (beta * jnp.exp(gc))[..., None]], axis=-1)
    sol = lax.linalg.triangular_solve(m, rhs, left_side=True, lower=True, unit_diagonal=True)
    u, w = sol[..., :dv], sol[..., dv:]
    attn = jnp.einsum("bhnid,bhnjd->bhnij", q, k) * decay
    q_dec = q * jnp.exp(gc)[..., None]
    k_st = k * jnp.exp(gc[..., -1:] - gc)[..., None]
    g_last = jnp.exp(gc[..., -1])

    def step(state, inp):
        u_c, w_c, q_c, k_c, a_c, gl = inp
        v_new = u_c - jnp.einsum("bhcd,bhde->bhce", w_c, state)
        o = jnp.einsum("bhcd,bhde->bhce", q_c, state) + jnp.einsum("bhij,bhje->bhie", a_c, v_new)
        state = state * gl[..., None, None] + jnp.einsum("bhcd,bhce->bhde", k_c, v_new)
        return state, o

    xs = tuple(jnp.moveaxis(a, 2, 0) for a in (u, w, q_dec, k_st, attn, g_last))
    s0 = jnp.zeros((bsz, h, dk, dv), f32)
    _, o = lax.scan(step, s0, xs)
    return o.transpose(1, 0, 3, 2, 4).reshape(bsz, t, h, dv)


def ssd_scan(x, dt, a, bm, cm):
    f32 = jnp.float32
    bsz, t, h, p = x.shape
    g, n = bm.shape[2], bm.shape[3]
    hg = h // g
    nc = t // CHUNK
    xc = x.astype(f32).reshape(bsz, nc, CHUNK, g, hg, p)
    dtc = dt.astype(f32).reshape(bsz, nc, CHUNK, g, hg)
    bc = bm.astype(f32).reshape(bsz, nc, CHUNK, g, n)
    cc = cm.astype(f32).reshape(bsz, nc, CHUNK, g, n)
    da_cs = jnp.cumsum(dtc * a.astype(f32).reshape(g, hg), axis=2)
    seg = da_cs[:, :, :, None] - da_cs[:, :, None, :]
    mask = jnp.tril(jnp.ones((CHUNK, CHUNK), bool))[:, :, None, None]
    lmat = jnp.exp(jnp.where(mask, seg, -jnp.inf))
    cb = jnp.einsum("bclgn,bcsgn->bclsg", cc, bc)
    wts = cb[..., None] * lmat * dtc[:, :, None]
    y_diag = jnp.einsum("bclsgh,bcsghp->bclghp", wts, xc)
    decay_states = jnp.exp(da_cs[:, :, -1:] - da_cs)
    states = jnp.einsum("bclgn,bclgh,bclghp->bcghpn", bc, decay_states * dtc, xc)
    chunk_decay = jnp.exp(da_cs[:, :, -1])

    def step(state, inp):
        st, dec = inp
        return state * dec[..., None, None] + st, state

    s0 = jnp.zeros((bsz, g, hg, p, n), f32)
    _, prev = lax.scan(step, s0, (jnp.moveaxis(states, 1, 0), jnp.moveaxis(chunk_decay, 1, 0)))
    prev = jnp.moveaxis(prev, 0, 1)
    y_off = jnp.einsum("bclgn,bcghpn,bclgh->bclghp", cc, prev, jnp.exp(da_cs))
    return (y_diag + y_off).reshape(bsz, t, h, p)


def forgetting_attention(q, k, v, log_f):
    bsz, t, h, dh = q.shape
    f_cum = jnp.cumsum(log_f.astype(jnp.float32), axis=1).transpose(0, 2, 1)
    qh, kh, vh = (a.transpose(0, 2, 1, 3) for a in (q, k, v))
    kpos = jnp.arange(t)
    scale = dh ** -0.5

    def block(i):
        start = i * D_QBLOCK
        qb = lax.dynamic_slice_in_dim(qh, start, D_QBLOCK, axis=2)
        fq = lax.dynamic_slice_in_dim(f_cum, start, D_QBLOCK, axis=2)
        s = jnp.einsum("bhqd,bhkd->bhqk", qb, kh).astype(jnp.float32) * scale
        s = s + fq[..., :, None] - f_cum[:, :, None, :]
        qpos = start + jnp.arange(D_QBLOCK)
        s = jnp.where(kpos[None, :] <= qpos[:, None], s, -jnp.inf)
        pr = jax.nn.softmax(s, axis=-1).astype(vh.dtype)
        return jnp.einsum("bhqk,bhkd->bhqd", pr, vh)

    o = lax.map(block, jnp.arange(t // D_QBLOCK))
    return o.transpose(1, 0, 3, 2, 4).reshape(bsz, t, h * dh)


def even_mixer(h, w_in, rel_bias, conv_w, a_log, dt_bias, norm_w, w_out):
    bsz, t, _ = h.shape
    proj = h @ w_in
    a_q, a_k, a_v, b_qkv, b_beta, b_a, b_z = split_cols(proj, EVEN_SPLIT)
    heads_a = lambda z: z.reshape(bsz, t, A_HEADS, A_HEAD_DIM)
    o_a = chunk_band_attention(heads_a(a_q), heads_a(a_k), heads_a(a_v), rel_bias)
    qkv = jax.nn.silu(causal_depthwise_conv(b_qkv, conv_w))
    b_q, b_k, b_v = (z.reshape(bsz, t, B_HEADS, B_HEAD_DIM) for z in split_cols(qkv, (B_W, B_W, B_W)))
    beta = jax.nn.sigmoid(b_beta.astype(jnp.float32))
    g = -jnp.exp(a_log.astype(jnp.float32)) * jax.nn.softplus(b_a.astype(jnp.float32) + dt_bias.astype(jnp.float32))
    o_b = gated_delta_rule(b_q, b_k, b_v, beta, g).astype(h.dtype)
    o_b = rms_norm(o_b, norm_w) * jax.nn.silu(b_z.reshape(bsz, t, B_HEADS, B_HEAD_DIM))
    return jnp.concatenate([o_a, o_b.reshape(bsz, t, B_W)], axis=-1) @ w_out


def odd_mixer(h, w_in, conv_w, conv_b, dt_bias, a_log, d_skip, norm_w, f_bias, w_out):
    bsz, t, _ = h.shape
    proj = h @ w_in
    c_z, c_xbc, c_dt, d_q, d_k, d_v, d_f = split_cols(proj, ODD_SPLIT)
    xbc = jax.nn.silu(causal_depthwise_conv(c_xbc, conv_w) + conv_b)
    c_x, c_b, c_c = split_cols(xbc, (C_W, C_BC, C_BC))
    c_x = c_x.reshape(bsz, t, C_HEADS, C_HEAD_DIM)
    dt = jax.nn.softplus(c_dt.astype(jnp.float32) + dt_bias.astype(jnp.float32))
    a = -jnp.exp(a_log.astype(jnp.float32))
    y = ssd_scan(c_x, dt, a, c_b.reshape(bsz, t, C_GROUPS, C_STATE), c_c.reshape(bsz, t, C_GROUPS, C_STATE))
    y = (y + d_skip.astype(jnp.float32)[:, None] * c_x.astype(jnp.float32)).astype(h.dtype)
    y = (y.reshape(bsz, t, C_W) * jax.nn.silu(c_z)).reshape(bsz, t, C_GROUPS, C_W // C_GROUPS)
    y = rms_norm(y, norm_w.reshape(C_GROUPS, C_W // C_GROUPS)).reshape(bsz, t, C_W)
    heads_d = lambda z: z.reshape(bsz, t, D_HEADS, D_HEAD_DIM)
    log_f = jax.nn.log_sigmoid(d_f.astype(jnp.float32) + f_bias.astype(jnp.float32))
    o_d = forgetting_attention(heads_d(d_q), heads_d(d_k), heads_d(d_v), log_f)
    return jnp.concatenate([y, o_d], axis=-1) @ w_out


def setup_inputs(seed: int = 0) -> dict:
    key = jax.random.key(seed)
    ks = jax.random.split(key, 24)
    f32 = jnp.float32
    nrm = lambda k, shape, scale: jax.random.normal(k, shape, f32) * scale

    def mamba_dt_bias(k, shape):
        dt = jnp.exp(jax.random.uniform(k, shape, f32, np.log(1e-3), np.log(1e-1)))
        return dt + jnp.log(-jnp.expm1(-dt))

    return {
        "x": nrm(ks[0], (BATCH, SEQ, D_MODEL), 1.0),
        "norm_mix": 1.0 + nrm(ks[1], (DEPTH, D_MODEL), 0.02),
        "norm_ffn": 1.0 + nrm(ks[2], (DEPTH, D_MODEL), 0.02),
        "norm_final": 1.0 + nrm(ks[3], (D_MODEL,), 0.02),
        "ffn_w_gate": nrm(ks[4], (DEPTH, D_MODEL, D_FF), D_MODEL ** -0.5),
        "ffn_w_up": nrm(ks[5], (DEPTH, D_MODEL, D_FF), D_MODEL ** -0.5),
        "ffn_w_down": nrm(ks[6], (DEPTH, D_FF, D_MODEL), D_FF ** -0.5),
        "ab_w_in": nrm(ks[7], (N_EVEN, D_MODEL, PROJ_EVEN), D_MODEL ** -0.5),
        "ab_rel_bias": nrm(ks[8], (N_EVEN, A_HEADS, 2 * A_MAX_REL + 1), 0.2),
        "ab_conv_w": nrm(ks[9], (N_EVEN, CONV_K, 3 * B_W), CONV_K ** -0.5),
        "ab_a_log": jnp.log(jax.random.uniform(ks[10], (N_EVEN, B_HEADS), f32, 1.0, 16.0)),
        "ab_dt_bias": mamba_dt_bias(ks[11], (N_EVEN, B_HEADS)),
        "ab_norm_w": 1.0 + nrm(ks[12], (N_EVEN, B_HEAD_DIM), 0.02),
        "ab_w_out": nrm(ks[13], (N_EVEN, A_W + B_W, D_MODEL), (A_W + B_W) ** -0.5),
        "cd_w_in": nrm(ks[14], (N_ODD, D_MODEL, PROJ_ODD), D_MODEL ** -0.5),
        "cd_conv_w": nrm(ks[15], (N_ODD, CONV_K, C_CONV_CH), CONV_K ** -0.5),
        "cd_conv_b": nrm(ks[16], (N_ODD, C_CONV_CH), 0.02),
        "cd_dt_bias": mamba_dt_bias(ks[17], (N_ODD, C_HEADS)),
        "cd_a_log": jnp.log(jax.random.uniform(ks[18], (N_ODD, C_HEADS), f32, 1.0, 16.0)),
        "cd_d_skip": 1.0 + nrm(ks[19], (N_ODD, C_HEADS), 0.1),
        "cd_norm_w": 1.0 + nrm(ks[20], (N_ODD, C_W), 0.02),
        "cd_f_bias": 2.0 + nrm(ks[21], (N_ODD, D_HEADS), 0.1),
        "cd_w_out": nrm(ks[22], (N_ODD, C_W + D_W, D_MODEL), (C_W + D_W) ** -0.5),
    }


def reference(x, norm_mix, norm_ffn, norm_final, ffn_w_gate, ffn_w_up, ffn_w_down,
              ab_w_in, ab_rel_bias, ab_conv_w, ab_a_log, ab_dt_bias, ab_norm_w, ab_w_out,
              cd_w_in, cd_conv_w, cd_conv_b, cd_dt_bias, cd_a_log, cd_d_skip, cd_norm_w,
              cd_f_bias, cd_w_out):
    for layer in range(DEPTH):
        h = rms_norm(x, norm_mix[layer])
        i = layer // 2
        if layer % 2 == 0:
            x = x + even_mixer(h, ab_w_in[i], ab_rel_bias[i], ab_conv_w[i], ab_a_log[i],
                               ab_dt_bias[i], ab_norm_w[i], ab_w_out[i])
        else:
            x = x + odd_mixer(h, cd_w_in[i], cd_conv_w[i], cd_conv_b[i], cd_dt_bias[i],
                              cd_a_log[i], cd_d_skip[i], cd_norm_w[i], cd_f_bias[i], cd_w_out[i])
        h = rms_norm(x, norm_ffn[layer])
        x = x + swiglu(h, ffn_w_gate[layer], ffn_w_up[layer], ffn_w_down[layer])
    return rms_norm(x, norm_final)
```

```cpp
#include <hip/hip_runtime.h>
#include <hip/hip_cooperative_groups.h>
#include <cstdio>
#include <cstdint>
namespace cg = cooperative_groups;
namespace pg8 {
#define PG8_LAS __attribute__((address_space(3)))
typedef unsigned short bf16_t;
typedef short bf16x8 __attribute__((ext_vector_type(8)));
typedef float f32x4 __attribute__((ext_vector_type(4)));
typedef unsigned u32x4 __attribute__((ext_vector_type(4)));
constexpr int BM = 256, BK = 64, HALF = 128, HTB = HALF * BK * 2  , STAGE_BYTES = 8 * HTB, NXCD = 8, WGM = 8;

__host__ __device__ __forceinline__ int lds_byte(int r, int c) { const int st = (r >> 4) * 2 + (c >> 5), rr = r & 15, cc = c & 31, ob = rr * 64 + cc * 2; return st * 1024 + (ob ^ (((ob >> 9) & 1) << 5)); }
__host__ __device__ __forceinline__ void stage_rc(int b, int& R, int& C) { const int st = b / 1024, sb = b % 1024, swz = sb ^ (((sb >> 9) & 1) << 5); R = (st >> 1) * 16 + swz / 64; C = (st & 1) * 32 + (swz % 64) / 2; }
__host__ __device__ __forceinline__ int perm32(int rho) { const int n = rho >> 4, i = rho & 15; return 8 * (i >> 2) + 4 * n + (i & 3); }

struct Unit { int pm, pn; };
struct Gemm { const bf16_t* A; const bf16_t* Bt; int M, N, K; };

struct StaticOrder {
    int nM, nN, nwg, G, c;
    __host__ __device__ void init(int M, int N, int G_, int c_) { nM = M / BM; nN = N / BM; nwg = nM * nN; G = G_; c = c_; }
    __host__ __device__ bool next(int i, Unit& u) const {
        const long L = (long)i * G + c; if (L >= nwg) return false;
        int wgid = (int)L; { const int q = nwg / NXCD, r = nwg % NXCD, xcd = wgid % NXCD, off = wgid / NXCD; wgid = (xcd < r ? xcd * (q + 1) : r * (q + 1) + (xcd - r) * q) + off; }
        const int nig = WGM * nN, gid = wgid / nig, fm = gid * WGM, gsz = (nM - fm) < WGM ? (nM - fm) : WGM;
        u.pm = fm + ((wgid % nig) % gsz); u.pn = (wgid % nig) / gsz; return true;
    }
    __device__ __forceinline__ void a_ready(const Unit&) const {}
    __device__ __forceinline__ void done(const Unit&) const {}
};

__device__ __forceinline__ unsigned cvt_pk_bf16(float lo, float hi) { unsigned r; asm volatile("v_cvt_pk_bf16_f32 %0, %1, %2" : "=v"(r) : "v"(lo), "v"(hi)); return r; }
typedef float f32x2 __attribute__((ext_vector_type(2)));
__device__ __forceinline__ f32x2 gelu_pk(f32x2 v) {
    const f32x2 av = __builtin_elementwise_abs(v), d = av * 0.2316418882f + 1.0f;
    f32x2 t; t.x = __builtin_amdgcn_rcpf(d.x); t.y = __builtin_amdgcn_rcpf(d.y);
    f32x2 q = t * 0.5307027145f + (-0.7265760135f); q = q * t + 0.7107068705f; q = q * t + (-0.142248368f); q = q * t + 0.127414796f; q = q * t;
    const f32x2 s = (v * v) * (-0.72134752044f);
    f32x2 e; e.x = __builtin_amdgcn_exp2f(s.x); e.y = __builtin_amdgcn_exp2f(s.y);
    const f32x2 m = v * (q * e), r = v - m;
    f32x2 o; o.x = v.x < 0.f ? m.x : r.x; o.y = v.y < 0.f ? m.y : r.y; return o;
}

template <int ACT  > struct EpiBf16 {
    static constexpr bool PERM = true, AFTER_DRAIN = false; static_assert(ACT == 0 || ACT == 1, "EpiBf16: ACT is 0 (none) or 1 (gelu_pk)");
    bf16_t* O; int ldc; const float* bias; int split_cols; size_t split_stride; float scale0;
    __device__ __forceinline__ void operator()(const f32x4 (&acc)[2][2][4][2], const Unit& u, int wr, int wc, int fr, int fq) const {
        const int row0 = u.pm * BM + wr * 64 + fr; int colt = u.pn * BM; bf16_t* base = O;
        float sc = 1.f; if (split_cols) { const int t = colt / split_cols; base += (size_t)t * split_stride; colt -= t * split_cols; if (t == 0) sc = scale0; }
        const int col0 = colt + wc * 32 + 8 * fq, bcol0 = u.pn * BM + wc * 32 + 8 * fq;
        f32x4 bv[2][2];
#pragma unroll
        for (int bj = 0; bj < 2; ++bj)
#pragma unroll
            for (int n = 0; n < 2; ++n) bv[bj][n] = bias ? *(const f32x4*)(bias + bcol0 + bj * HALF + 4 * n) : (f32x4){0.f, 0.f, 0.f, 0.f};
#pragma unroll
        for (int ai = 0; ai < 2; ++ai)
#pragma unroll
            for (int m = 0; m < 4; ++m) { bf16_t* rowp = base + (size_t)(row0 + ai * HALF + m * 16) * ldc + col0;
#pragma unroll
                for (int bj = 0; bj < 2; ++bj) { f32x4 v0 = acc[ai][bj][m][0] + bv[bj][0], v1 = acc[ai][bj][m][1] + bv[bj][1];
                    if (ACT == 1) { f32x2 a = gelu_pk((f32x2){v0[0], v0[1]}), b = gelu_pk((f32x2){v0[2], v0[3]}), c = gelu_pk((f32x2){v1[0], v1[1]}), d = gelu_pk((f32x2){v1[2], v1[3]});
                        v0 = (f32x4){a.x, a.y, b.x, b.y}; v1 = (f32x4){c.x, c.y, d.x, d.y}; }
                    v0 = v0 * sc; v1 = v1 * sc; u32x4 w; w.x = cvt_pk_bf16(v0[0], v0[1]); w.y = cvt_pk_bf16(v0[2], v0[3]); w.z = cvt_pk_bf16(v1[0], v1[1]); w.w = cvt_pk_bf16(v1[2], v1[3]);
                    *(u32x4*)(rowp + bj * HALF) = w; } }
    }
};
template <class Epi, class Sched, bool ALIGN_EPI = false, bool SP2 = false>
__device__ __forceinline__ void gemm_phase(PG8_LAS unsigned char* lds, const Gemm g, const Sched& S, const Epi& E) {
    const int tid = threadIdx.x, wid = __builtin_amdgcn_readfirstlane(tid >> 6), lane = tid & 63, wr = wid >> 2, wc = wid & 3, fr = lane & 15, fq = lane >> 4;
    const int K = g.K, nt = K / BK;
    unsigned voffA[2], voffB[2];
#pragma unroll
    for (int i = 0; i < 2; ++i) { int R, C; stage_rc(tid * 16 + i * 8192, R, C); const int Rb = Epi::PERM ? ((R & ~31) + perm32(R & 31)) : R;
        voffA[i] = (unsigned)(R * K + C) * 2u; voffB[i] = (unsigned)(Rb * K + C) * 2u; }
    const size_t kstep = (size_t)(BK * 2);
    const size_t hstep = (size_t)HALF * K * 2;
    const size_t tstep = 2 * hstep;
    const unsigned ldsw = (unsigned)wid * 1024u;
    const int aoff = lds_byte(wr * 64 + fr, fq * 8), boff = lds_byte(wc * 32 + fr, fq * 8);
#define PG8_SA(b, h) (((b) * 2 + (h)) * HTB)
#define PG8_SB(b, h) ((4 + (b) * 2 + (h)) * HTB)
#define PG8_STAGE(bufoff, gbase, voff) do { _Pragma("unroll") for (int _i = 0; _i < 2; ++_i) \
        __builtin_amdgcn_global_load_lds((const unsigned*)((const char*)(gbase) + (voff)[_i]), (PG8_LAS unsigned*)(lds + (bufoff) + ldsw + _i * 8192), 16, 0, 0); } while (0)
#define PG8_LDA(dst, b, h) do { _Pragma("unroll") for (int m = 0; m < 4; ++m) _Pragma("unroll") for (int k = 0; k < 2; ++k) dst[m][k] = *(const PG8_LAS bf16x8*)(lds + PG8_SA(b, h) + aoff + m * 2048 + k * 1024); } while (0)
#define PG8_LDB(dst, b, h) do { _Pragma("unroll") for (int n = 0; n < 2; ++n) _Pragma("unroll") for (int k = 0; k < 2; ++k) dst[n][k] = *(const PG8_LAS bf16x8*)(lds + PG8_SB(b, h) + boff + n * 2048 + k * 1024); } while (0)
#define PG8_MMA(ai, bj, At, Bt) do { __builtin_amdgcn_s_setprio(1); _Pragma("unroll") for (int m = 0; m < 4; ++m) _Pragma("unroll") for (int n = 0; n < 2; ++n) _Pragma("unroll") for (int k = 0; k < 2; ++k) \
        acc[ai][bj][m][n] = __builtin_amdgcn_mfma_f32_16x16x32_bf16(Bt[n][k], At[m][k], acc[ai][bj][m][n], 0, 0, 0); __builtin_amdgcn_s_setprio(0); } while (0)
#define PG8_WAIT_V(n) asm volatile("s_waitcnt vmcnt(" #n ")" ::: "memory")
#define PG8_WAIT_L(n) asm volatile("s_waitcnt lgkmcnt(" #n ")" ::: "memory")
#define PG8_BAR __builtin_amdgcn_s_barrier()
#define PG8_SCHED __builtin_amdgcn_sched_barrier(0)
    Unit cur, nxt; int ui = 0;
    if (!S.next(0, cur)) return;
    f32x4 acc[2][2][4][2];
#pragma unroll
    for (int a = 0; a < 2; ++a)
#pragma unroll
        for (int b = 0; b < 2; ++b)
#pragma unroll
            for (int m = 0; m < 4; ++m)
#pragma unroll
                for (int n = 0; n < 2; ++n) acc[a][b][m][n] = (f32x4){0.f, 0.f, 0.f, 0.f};
    bf16x8 At[4][2], B0[2][2], B1[2][2];
    const char* cA = (const char*)g.A + (size_t)cur.pm * tstep; const char* cB = (const char*)g.Bt + (size_t)cur.pn * tstep;
    S.a_ready(cur);
    if constexpr (SP2) {
        PG8_STAGE(PG8_SB(0, 0), cB, voffB); PG8_STAGE(PG8_SB(0, 1), cB + hstep, voffB); PG8_STAGE(PG8_SA(0, 0), cA, voffA); PG8_STAGE(PG8_SA(0, 1), cA + hstep, voffA);
        if (wr == 1) PG8_BAR;
        PG8_WAIT_V(2); PG8_BAR;
        PG8_STAGE(PG8_SB(1, 0), cB + kstep, voffB); PG8_STAGE(PG8_SA(1, 0), cA + kstep, voffA); PG8_STAGE(PG8_SB(1, 1), cB + hstep + kstep, voffB);
        PG8_WAIT_V(6); PG8_BAR;
    } else {
        PG8_STAGE(PG8_SB(0, 0), cB, voffB); PG8_STAGE(PG8_SA(0, 0), cA, voffA); PG8_STAGE(PG8_SB(0, 1), cB + hstep, voffB); PG8_STAGE(PG8_SA(0, 1), cA + hstep, voffA);
        if (wr == 1) PG8_BAR;
        PG8_WAIT_V(4); PG8_BAR;
        PG8_STAGE(PG8_SB(1, 0), cB + kstep, voffB); PG8_STAGE(PG8_SA(1, 0), cA + kstep, voffA); PG8_STAGE(PG8_SB(1, 1), cB + hstep + kstep, voffB);
        PG8_WAIT_V(6); PG8_BAR;
    }
    for (;;) {
        const bool has_next = S.next(ui + 1, nxt);
        const char* nA = has_next ? (const char*)g.A + (size_t)nxt.pm * tstep : cA; const char* nB = has_next ? (const char*)g.Bt + (size_t)nxt.pn * tstep : cB;
        for (int t = 0; t < nt; t += 2) {
            const bool last = (t == nt - 2);
            const char* a1 = cA + (size_t)(t + 1) * kstep;
            const char* a2 = last ? nA : cA + (size_t)(t + 2) * kstep; const char* b2 = last ? nB : cB + (size_t)(t + 2) * kstep;
            const char* a3 = a2 + kstep; const char* b3 = b2 + kstep;
            if (last && has_next) S.a_ready(nxt);
            if constexpr (SP2) {
            PG8_LDB(B0, 0, 0); PG8_LDB(B1, 0, 1); PG8_SCHED; PG8_LDA(At, 0, 0); PG8_STAGE(PG8_SA(1, 1), a1 + hstep, voffA);
            PG8_WAIT_V(8); PG8_WAIT_L(0); PG8_BAR; PG8_MMA(0, 0, At, B0); PG8_MMA(0, 1, At, B1); PG8_BAR; PG8_SCHED;
            PG8_LDA(At, 0, 1); PG8_STAGE(PG8_SB(0, 0), b2, voffB); PG8_STAGE(PG8_SB(0, 1), b2 + hstep, voffB); PG8_STAGE(PG8_SA(0, 0), a2, voffA);
            PG8_WAIT_V(8); PG8_WAIT_L(0); PG8_BAR; PG8_MMA(1, 0, At, B0); PG8_MMA(1, 1, At, B1); PG8_BAR; PG8_SCHED;
            PG8_LDB(B0, 1, 0); PG8_LDB(B1, 1, 1); PG8_SCHED; PG8_LDA(At, 1, 0); PG8_STAGE(PG8_SA(0, 1), a2 + hstep, voffA);
            PG8_WAIT_V(8); PG8_WAIT_L(0); PG8_BAR; PG8_MMA(0, 0, At, B0); PG8_MMA(0, 1, At, B1); PG8_BAR; PG8_SCHED;
            PG8_LDA(At, 1, 1); PG8_STAGE(PG8_SB(1, 0), b3, voffB); PG8_STAGE(PG8_SB(1, 1), b3 + hstep, voffB); PG8_STAGE(PG8_SA(1, 0), a3, voffA);
            PG8_WAIT_V(8); PG8_WAIT_L(0); PG8_BAR; PG8_MMA(1, 0, At, B0); PG8_MMA(1, 1, At, B1); PG8_BAR; PG8_SCHED;
            } else {
            PG8_LDB(B0, 0, 0); PG8_SCHED; PG8_LDA(At, 0, 0); PG8_STAGE(PG8_SA(1, 1), a1 + hstep, voffA);
            PG8_WAIT_L(8); PG8_BAR; PG8_WAIT_L(0); PG8_MMA(0, 0, At, B0); PG8_BAR; PG8_SCHED;
            PG8_LDB(B1, 0, 1); PG8_STAGE(PG8_SB(0, 0), b2, voffB);
            PG8_BAR; PG8_WAIT_L(0); PG8_MMA(0, 1, At, B1); PG8_BAR;
            PG8_LDA(At, 0, 1); PG8_STAGE(PG8_SA(0, 0), a2, voffA);
            PG8_BAR; PG8_WAIT_L(0); PG8_MMA(1, 0, At, B0); PG8_BAR; PG8_SCHED;
            PG8_STAGE(PG8_SB(0, 1), b2 + hstep, voffB);
            PG8_WAIT_V(6); PG8_BAR; PG8_MMA(1, 1, At, B1); PG8_BAR;
            PG8_LDB(B0, 1, 0); PG8_SCHED; PG8_LDA(At, 1, 0); PG8_STAGE(PG8_SA(0, 1), a2 + hstep, voffA);
            PG8_WAIT_L(8); PG8_BAR; PG8_WAIT_L(0); PG8_MMA(0, 0, At, B0); PG8_BAR; PG8_SCHED;
            PG8_LDB(B1, 1, 1); PG8_STAGE(PG8_SB(1, 0), b3, voffB);
            PG8_BAR; PG8_WAIT_L(0); PG8_MMA(0, 1, At, B1); PG8_BAR;
            PG8_LDA(At, 1, 1); PG8_STAGE(PG8_SA(1, 0), a3, voffA);
            PG8_BAR; PG8_WAIT_L(0); PG8_MMA(1, 0, At, B0); PG8_BAR; PG8_SCHED;
            PG8_STAGE(PG8_SB(1, 1), b3 + hstep, voffB);
            PG8_WAIT_V(6); PG8_BAR; PG8_MMA(1, 1, At, B1); PG8_BAR;
            }
        }
        if constexpr (ALIGN_EPI) { if (wr == 0) PG8_BAR; }
        if constexpr (!Epi::AFTER_DRAIN) { E(acc, cur, wr, wc, fr, fq); S.done(cur); }
        if (!has_next) break;
#pragma unroll
        for (int a = 0; a < 2; ++a)
#pragma unroll
            for (int b = 0; b < 2; ++b)
#pragma unroll
                for (int m = 0; m < 4; ++m)
#pragma unroll
                    for (int n = 0; n < 2; ++n) acc[a][b][m][n] = (f32x4){0.f, 0.f, 0.f, 0.f};
        cur = nxt; cA = nA; cB = nB; ++ui;
        if constexpr (ALIGN_EPI) { if (wr == 1) PG8_BAR; }
    }
    PG8_WAIT_V(0);
    if constexpr (!ALIGN_EPI) { if (wr == 0) PG8_BAR; }
    PG8_BAR;
    if constexpr (Epi::AFTER_DRAIN) { E.fused(acc, cur, wr, wc, fr, fq, lds, wid, lane); S.done(cur); }
#undef PG8_SA
#undef PG8_SB
#undef PG8_STAGE
#undef PG8_LDA
#undef PG8_LDB
#undef PG8_MMA
#undef PG8_WAIT_V
#undef PG8_WAIT_L
#undef PG8_BAR
#undef PG8_SCHED
}
}

constexpr int BATCH = 2, SEQ = 8192, DM = 1024, FF = 2816, MROWS = BATCH * SEQ;
constexpr int NP0 = 3584, NP1 = 3072, LDW0 = 3592, LDW1 = 3088;
constexpr int NTHR = 512, NWAVES = 8;
constexpr int LDS_BYTES = 147456;
constexpr size_t MiB = 1u << 20;
constexpr size_t WS_WIN0 = 1 * MiB, WS_WOUT0 = 8 * MiB, WS_WGU0 = 10 * MiB, WS_WDN0 = 21 * MiB;
constexpr size_t WS_WIN1 = 27 * MiB, WS_WOUT1 = 33 * MiB, WS_WGU1 = 35 * MiB, WS_WDN1 = 46 * MiB;
constexpr size_t WS_GATES = 52 * MiB, WS_XN = 53 * MiB, WS_MIX = 85 * MiB, WS_PROJ = 117 * MiB, WS_SPARE = 229 * MiB;
constexpr size_t WS_XBC = 213 * MiB;

#define LAS __attribute__((address_space(3)))
typedef unsigned short bf16;
typedef float f32x4 __attribute__((ext_vector_type(4)));
typedef unsigned u32x4 __attribute__((ext_vector_type(4)));
typedef unsigned u32x2 __attribute__((ext_vector_type(2)));
#define LDS_WAIT() asm volatile("s_waitcnt lgkmcnt(0)" ::: "memory")
#define LDS_BARRIER() do { asm volatile("s_waitcnt lgkmcnt(0)" ::: "memory"); __builtin_amdgcn_s_barrier(); asm volatile("" ::: "memory"); } while (0)

__device__ __forceinline__ float bf2f(unsigned v) { return __uint_as_float(v << 16); }
__device__ __forceinline__ float bflo(unsigned w) { return __uint_as_float(w << 16); }
__device__ __forceinline__ float bfhi(unsigned w) { return __uint_as_float(w & 0xffff0000u); }
__device__ __forceinline__ unsigned f2bf(float f) { unsigned u = __float_as_uint(f); return (u + 0x7fffu + ((u >> 16) & 1u)) >> 16; }
__device__ __forceinline__ unsigned pk2(float lo, float hi) { return f2bf(lo) | (f2bf(hi) << 16); }
__device__ __forceinline__ float silu_f(float x) { return x / (1.f + __expf(-x)); }
__device__ __forceinline__ float sigmoid_f(float x) { return 1.f / (1.f + __expf(-x)); }
__device__ __forceinline__ float softplus_f(float x) { return fmaxf(x, 0.f) + log1pf(__expf(-fabsf(x))); }
__device__ __forceinline__ float wave_sum(float v) {
#pragma unroll
    for (int o = 1; o < 64; o <<= 1) v += __shfl_xor(v, o);
    return v;
}

__device__ __forceinline__ void unpack8(const u32x4 w, float* f) { f[0] = bflo(w.x); f[1] = bfhi(w.x); f[2] = bflo(w.y); f[3] = bfhi(w.y); f[4] = bflo(w.z); f[5] = bfhi(w.z); f[6] = bflo(w.w); f[7] = bfhi(w.w); }

struct Params { const float* in[23]; float* out; unsigned char* ws; };

struct TJob { const float* s0; const float* s1; bf16* dst; int K, N, ld, thr, mode; };
__device__ __forceinline__ void transpose_item(const TJob J, LAS float* scr, int item, int lane) {
    const int nblk = J.N / 32, kb = item / nblk, nb = item % nblk, k0 = 64 * kb, n0 = 32 * nb;
    const int nd = n0 + (lane & 31);
    const float* src;
    if (J.mode == 0) src = J.s0 + (nd + (nd >= J.thr ? 8 : 0));
    else { const int c = (nd >> 3) * 4 + (nd & 3); src = ((nd & 4) ? J.s1 : J.s0) + c; }
    float tv[32];
#pragma unroll
    for (int i = 0; i < 32; ++i) tv[i] = src[(size_t)(k0 + 2 * i + (lane >> 5)) * J.ld];
#pragma unroll
    for (int i = 0; i < 32; ++i) scr[(2 * i + (lane >> 5)) * 33 + (lane & 31)] = tv[i];
    LDS_WAIT();
    const int c = lane & 7;
#pragma unroll
    for (int j = 0; j < 4; ++j) { const int n = (lane >> 3) + 8 * j; const LAS float* s = scr + (8 * c) * 33 + n;
        u32x4 o; o.x = pk2(s[0 * 33], s[1 * 33]); o.y = pk2(s[2 * 33], s[3 * 33]); o.z = pk2(s[4 * 33], s[5 * 33]); o.w = pk2(s[6 * 33], s[7 * 33]);
        *(u32x4*)(J.dst + (size_t)(n0 + n) * J.K + k0 + 8 * c) = o; }
    LDS_WAIT();
}
__device__ __forceinline__ void weights_phase(const Params& p, LAS unsigned char* lds, int gw, int NGW, int wave, int lane, int layer) {
    LAS float* scr = (LAS float*)(lds + wave * 16384);
    unsigned char* ws = p.ws;
    constexpr int I_IN0 = 16 * (NP0 / 32), I_OUT = 16 * 32, I_GU = 16 * (2 * FF / 32), I_DN = (FF / 64) * 32, I_IN1 = 16 * (NP1 / 32);
    constexpr int PER_L0 = I_IN0 + I_OUT + I_GU + I_DN, PER_L1 = I_IN1 + I_OUT + I_GU + I_DN;
    const int it_lo = layer == 0 ? 0 : layer == 1 ? PER_L0 : layer == 2 ? PER_L0 + PER_L1 / 2 : layer == 3 ? 0 : layer == 4 ? I_IN0 : layer == 5 ? I_IN0 : PER_L0;
    const int it_hi = layer == 0 ? PER_L0 : layer == 1 ? PER_L0 + PER_L1 / 2 : layer == 2 ? PER_L0 + PER_L1 : layer == 3 ? I_IN0 : layer == 4 ? PER_L0 + PER_L1 : layer == 5 ? PER_L0 : PER_L0 + PER_L1;
    for (int it = it_lo + gw; it < it_hi; it += NGW) {
        int r = it; TJob J;
        if (r < PER_L0) {
            if (r < I_IN0) J = TJob{p.in[7], nullptr, (bf16*)(ws + WS_WIN0), DM, NP0, LDW0, 3072, 0};
            else if ((r -= I_IN0) < I_OUT) J = TJob{p.in[13], nullptr, (bf16*)(ws + WS_WOUT0), DM, DM, DM, 1 << 30, 0};
            else if ((r -= I_OUT) < I_GU) J = TJob{p.in[4], p.in[5], (bf16*)(ws + WS_WGU0), DM, 2 * FF, FF, 0, 1};
            else { r -= I_GU; J = TJob{p.in[6], nullptr, (bf16*)(ws + WS_WDN0), FF, DM, DM, 1 << 30, 0}; }
        } else {
            r -= PER_L0;
            if (r < I_IN1) J = TJob{p.in[14], nullptr, (bf16*)(ws + WS_WIN1), DM, NP1, LDW1, 1536, 0};
            else if ((r -= I_IN1) < I_OUT) J = TJob{p.in[22], nullptr, (bf16*)(ws + WS_WOUT1), DM, DM, DM, 1 << 30, 0};
            else if ((r -= I_OUT) < I_GU) J = TJob{p.in[4] + (size_t)DM * FF, p.in[5] + (size_t)DM * FF, (bf16*)(ws + WS_WGU1), DM, 2 * FF, FF, 0, 1};
            else { r -= I_GU; J = TJob{p.in[6] + (size_t)FF * DM, nullptr, (bf16*)(ws + WS_WDN1), FF, DM, DM, 1 << 30, 0}; }
        }
        transpose_item(J, scr, r, lane);
    }
}

template <int GM>
__device__ __forceinline__ void rows_phase(const float* X, const float* nw, bf16* XN, const float* Win, const float* pA, const float* pB,
                                           float* GATES, LAS unsigned char* lds, int gw, int NGW, int tid, int lane) {
    constexpr int NG = GM == 1 ? 8 : 16;
    LAS float* Wl = (LAS float*)lds;
    if (GM != 0) {
        float tmpw[2 * NG];
#pragma unroll
        for (int i = 0; i < 2 * NG; ++i) { const int idx = tid + NTHR * i, k = idx / NG, g = idx % NG;
            int col; int ld;
            if (GM == 1) { col = 3072 + g; ld = LDW0; } else { col = g < 8 ? 1536 + g : 3080 + (g - 8); ld = LDW1; }
            tmpw[i] = Win[(size_t)k * ld + col]; }
#pragma unroll
        for (int i = 0; i < 2 * NG; ++i) { const int idx = tid + NTHR * i, k = idx / NG, g = idx % NG; Wl[g * 1024 + k] = tmpw[i]; }
        __syncthreads();
    }
    f32x4 wv[4];
#pragma unroll
    for (int j = 0; j < 4; ++j) wv[j] = *(const f32x4*)(nw + 256 * j + 4 * lane);
    for (int mb = gw; mb < MROWS; mb += 4 * NGW) {
        f32x4 vv[4][4];
#pragma unroll
        for (int k = 0; k < 4; ++k) { const size_t m = (size_t)mb + (size_t)k * NGW; if (m < MROWS) { const f32x4* xr = (const f32x4*)(X + m * DM) + lane;
#pragma unroll
            for (int j = 0; j < 4; ++j) vv[k][j] = xr[64 * j]; } }
#pragma unroll
        for (int k = 0; k < 4; ++k) { const size_t m = (size_t)mb + (size_t)k * NGW; if (m < MROWS) {
        f32x4 v[4]; float s = 0.f;
#pragma unroll
        for (int j = 0; j < 4; ++j) { v[j] = vv[k][j]; s += (v[j].x * v[j].x + v[j].y * v[j].y) + (v[j].z * v[j].z + v[j].w * v[j].w); }
        const float rstd = 1.f / sqrtf(wave_sum(s) * (1.f / DM) + 1e-6f);
#pragma unroll
        for (int j = 0; j < 4; ++j) v[j] = v[j] * rstd * wv[j];
        u32x2* o8 = (u32x2*)(XN + m * DM) + lane;
#pragma unroll
        for (int j = 0; j < 4; ++j) { u32x2 w; w.x = pk2(v[j].x, v[j].y); w.y = pk2(v[j].z, v[j].w); o8[64 * j] = w; }
        if (GM != 0) {
            float ga[NG];
#pragma unroll
            for (int g = 0; g < NG; ++g) {
                float a = 0.f;
#pragma unroll
                for (int j = 0; j < 4; ++j) { const f32x4 w4 = *(const LAS f32x4*)(Wl + g * 1024 + 256 * j + 4 * lane); a += (v[j].x * w4.x + v[j].y * w4.y) + (v[j].z * w4.z + v[j].w * w4.w); }
                ga[g] = a;
            }
            int gidx = 0;
#define GATE_STEP(N, OFF) do { const bool up = (lane & (OFF)) != 0; \
                _Pragma("unroll") for (int i = 0; i < (N); ++i) { const float keep = up ? ga[i + (N)] : ga[i], send = up ? ga[i] : ga[i + (N)]; ga[i] = keep + __shfl_xor(send, (OFF)); } \
                gidx = gidx * 2 + (up ? 1 : 0); } while (0)
            if constexpr (NG == 16) { GATE_STEP(8, 32); GATE_STEP(4, 16); GATE_STEP(2, 8); GATE_STEP(1, 4); }
            else { GATE_STEP(4, 32); GATE_STEP(2, 16); GATE_STEP(1, 8); }
#undef GATE_STEP
            float val = ga[0];
            if (NG == 16) { val += __shfl_xor(val, 2); val += __shfl_xor(val, 1); } else { val += __shfl_xor(val, 4); val += __shfl_xor(val, 2); val += __shfl_xor(val, 1); }
            if ((lane & (NG == 16 ? 3 : 7)) == 0) {
                float r;
                if (GM == 1) { if (gidx < 4) r = sigmoid_f(val); else { const int h = gidx - 4; r = -__expf(pA[h]) * softplus_f(val + pB[h]); } }
                else { if (gidx < 8) r = softplus_f(val + pA[gidx]); else r = -softplus_f(-(val + pB[gidx - 8])); }
                GATES[m * 16 + gidx] = r;
            }
        }
        } }
    }
}

namespace pg8 {
struct EpiResF32 {
    static constexpr bool PERM = false, AFTER_DRAIN = false;
    const float* base; float* out; int ldc;
    __device__ __forceinline__ void operator()(const f32x4 (&acc)[2][2][4][2], const Unit& u, int wr, int wc, int fr, int fq) const {
        const int col0 = u.pn * BM + wc * 32 + 4 * fq;
#pragma unroll
        for (int ai = 0; ai < 2; ++ai)
#pragma unroll
            for (int m = 0; m < 4; ++m) { const size_t off = (size_t)(u.pm * BM + ai * HALF + wr * 64 + m * 16 + fr) * ldc + col0;
#pragma unroll
                for (int bj = 0; bj < 2; ++bj)
#pragma unroll
                    for (int n = 0; n < 2; ++n) { const f32x4 bs = *(const f32x4*)(base + off + bj * HALF + n * 16); *(f32x4*)(out + off + bj * HALF + n * 16) = bs + acc[ai][bj][m][n]; } }
    }
};
struct EpiSwiglu {
    static constexpr bool PERM = true, AFTER_DRAIN = false;
    bf16_t* H; int ldh;
    __device__ __forceinline__ void operator()(const f32x4 (&acc)[2][2][4][2], const Unit& u, int wr, int wc, int fr, int fq) const {
        const int row0 = u.pm * BM + wr * 64 + fr; const int hcol0 = (u.pn * BM + wc * 32 + 8 * fq) >> 1;
#pragma unroll
        for (int ai = 0; ai < 2; ++ai)
#pragma unroll
            for (int m = 0; m < 4; ++m) { bf16_t* rowp = H + (size_t)(row0 + ai * HALF + m * 16) * ldh + hcol0;
#pragma unroll
                for (int bj = 0; bj < 2; ++bj) { const f32x4 g = acc[ai][bj][m][0], v = acc[ai][bj][m][1];
                    float h0 = g[0] / (1.f + __expf(-g[0])) * v[0], h1 = g[1] / (1.f + __expf(-g[1])) * v[1], h2 = g[2] / (1.f + __expf(-g[2])) * v[2], h3 = g[3] / (1.f + __expf(-g[3])) * v[3];
                    typedef unsigned u32x2v __attribute__((ext_vector_type(2))); u32x2v w; w.x = cvt_pk_bf16(h0, h1); w.y = cvt_pk_bf16(h2, h3);
                    *(u32x2v*)(rowp + bj * (HALF / 2)) = w; } }
    }
};
template <int MODE>
struct EpiResRms {
    static constexpr bool PERM = false, AFTER_DRAIN = true;
    const float* base; float* out; bf16_t* xn; int ldc; const float* nw; float* slots; unsigned* cnt;
    __device__ __forceinline__ void fused(f32x4 (&acc)[2][2][4][2], const Unit& u, int wr, int wc, int fr, int fq, PG8_LAS unsigned char* lds, int wid, int lane) const {
        PG8_LAS float* P = (PG8_LAS float*)lds;
        PG8_LAS float* S = (PG8_LAS float*)(lds + 4096);
        const int col0 = u.pn * BM + wc * 32 + 4 * fq;
#pragma unroll
        for (int ai = 0; ai < 2; ++ai)
#pragma unroll
            for (int m = 0; m < 4; ++m) { const int rl = ai * HALF + wr * 64 + m * 16 + fr; const size_t off = (size_t)(u.pm * BM + rl) * ldc + col0; float ss = 0.f;
#pragma unroll
                for (int bj = 0; bj < 2; ++bj)
#pragma unroll
                    for (int n = 0; n < 2; ++n) { const f32x4 v = *(const f32x4*)(base + off + bj * HALF + n * 16) + acc[ai][bj][m][n]; acc[ai][bj][m][n] = v;
                        ss += (v[0] * v[0] + v[1] * v[1]) + (v[2] * v[2] + v[3] * v[3]); }
                ss += __shfl_xor(ss, 16); ss += __shfl_xor(ss, 32);
                if (fq == 0) P[rl * 4 + wc] = ss;
                if (m & 1) asm volatile("" ::: "memory"); }
        asm volatile("s_waitcnt lgkmcnt(0)" ::: "memory"); __builtin_amdgcn_s_barrier(); asm volatile("" ::: "memory");
        const int t = wid * 64 + lane;
        if (t < 256) { const float tot = (P[t * 4] + P[t * 4 + 1]) + (P[t * 4 + 2] + P[t * 4 + 3]);
            __hip_atomic_store(slots + (size_t)(u.pm * BM + t) * 4 + u.pn, tot, __ATOMIC_RELAXED, __HIP_MEMORY_SCOPE_AGENT); }
        asm volatile("s_waitcnt vmcnt(0)" ::: "memory");
        if (lane == 0) __hip_atomic_fetch_add(cnt + 64 * u.pm, 1u, __ATOMIC_RELAXED, __HIP_MEMORY_SCOPE_AGENT);
        if (wid == 0) {
            unsigned spins = 0;
            while ((unsigned)__builtin_amdgcn_readfirstlane(__hip_atomic_load(cnt + 64 * u.pm, __ATOMIC_RELAXED, __HIP_MEMORY_SCOPE_AGENT)) < 32u) { __builtin_amdgcn_s_sleep(2); if (++spins > (1u << 18)) break; }
            __builtin_amdgcn_fence(__ATOMIC_ACQUIRE, "agent");
        }
        asm volatile("s_waitcnt vmcnt(0) lgkmcnt(0)" ::: "memory"); __builtin_amdgcn_s_barrier(); asm volatile("" ::: "memory");
        if (t < 256) { const float* sl = slots + (size_t)(u.pm * BM + t) * 4;
            const float tot = (__hip_atomic_load(sl, __ATOMIC_RELAXED, __HIP_MEMORY_SCOPE_AGENT) + __hip_atomic_load(sl + 1, __ATOMIC_RELAXED, __HIP_MEMORY_SCOPE_AGENT))
                            + (__hip_atomic_load(sl + 2, __ATOMIC_RELAXED, __HIP_MEMORY_SCOPE_AGENT) + __hip_atomic_load(sl + 3, __ATOMIC_RELAXED, __HIP_MEMORY_SCOPE_AGENT));
            S[t] = 1.f / sqrtf(tot * (1.f / 1024.f) + 1e-6f); }
        asm volatile("s_waitcnt vmcnt(0) lgkmcnt(0)" ::: "memory"); __builtin_amdgcn_s_barrier(); asm volatile("" ::: "memory");
        f32x4 wv[2][2];
#pragma unroll
        for (int bj = 0; bj < 2; ++bj)
#pragma unroll
            for (int n = 0; n < 2; ++n) wv[bj][n] = *(const f32x4*)(nw + col0 + bj * HALF + n * 16);
#pragma unroll
        for (int ai = 0; ai < 2; ++ai)
#pragma unroll
            for (int m = 0; m < 4; ++m) { const int rl = ai * HALF + wr * 64 + m * 16 + fr; const size_t off = (size_t)(u.pm * BM + rl) * ldc + col0; const float rs = S[rl];
#pragma unroll
                for (int bj = 0; bj < 2; ++bj)
#pragma unroll
                    for (int n = 0; n < 2; ++n) { const f32x4 v = acc[ai][bj][m][n]; const f32x4 y = v * rs * wv[bj][n];
                        if (MODE == 0) { *(f32x4*)(out + off + bj * HALF + n * 16) = v;
                            typedef unsigned u32x2v __attribute__((ext_vector_type(2))); u32x2v w; w.x = cvt_pk_bf16(y[0], y[1]); w.y = cvt_pk_bf16(y[2], y[3]); *(u32x2v*)(xn + off + bj * HALF + n * 16) = w; }
                        else *(f32x4*)(out + off + bj * HALF + n * 16) = y; } }
    }
};
}
#define XB_TMO      128
#define XB_XCNT(j)  (256  + 64 * (j))
#define XB_XSUB(j)  (1280 + 64 * (j))
#define XB_XGEN(j)  (2304 + 64 * (j))
#define XB_TOP      3328
#define XB_TOPGEN   3392
#define XCD_BAR_WORDS 3456
#define XB_SPIN_CAP (1u << 18)

__device__ __forceinline__ unsigned xb_ld(unsigned* p)              { return __hip_atomic_load(p, __ATOMIC_RELAXED, __HIP_MEMORY_SCOPE_AGENT); }
__device__ __forceinline__ unsigned xb_add(unsigned* p, unsigned v) { return __hip_atomic_fetch_add(p, v, __ATOMIC_RELAXED, __HIP_MEMORY_SCOPE_AGENT); }
__device__ __forceinline__ unsigned xb_xcc_id() { return (unsigned)__builtin_amdgcn_s_getreg((3 << 11) | 20) & 0xFu; }
#define XB_SPIN(cond, bar) do { unsigned _sp = 0; while (cond) { __builtin_amdgcn_s_sleep(1); \
    if ((++_sp & 255u) == 0u) { if (xb_ld(&(bar)[XB_TMO])) break; if (_sp > XB_SPIN_CAP) { atomicAdd(&(bar)[XB_TMO], 1u); break; } } } } while (0)

struct XcdBarrier {
    unsigned* bar; unsigned x;
    volatile LAS unsigned* st;
};

__device__ __forceinline__ XcdBarrier xcd_barrier_post(unsigned* bar, volatile LAS unsigned* st) {
    XcdBarrier b; b.bar = bar; b.x = xb_xcc_id(); b.st = st;
    if (threadIdx.x == 0) (void)xb_add(&bar[XB_XCNT(b.x)], 1u);
    return b;
}
__device__ __forceinline__ void xcd_barrier_complete(unsigned* bar, unsigned x, unsigned& nloc, unsigned& nx) {
    const unsigned G = gridDim.x * gridDim.y * gridDim.z;
    unsigned sum, cnt, mine, sp = 0u;
    for (;;) {
        sum = 0u; cnt = 0u; mine = 0u;
#pragma unroll
        for (unsigned j = 0; j < 16; ++j) { const unsigned c = xb_ld(&bar[XB_XCNT(j)]); sum += c; cnt += (c > 0u) ? 1u : 0u; mine = (j == x) ? c : mine; }
        if (sum == G) break;
        __builtin_amdgcn_s_sleep(1);
        if ((++sp & 255u) == 0u) { if (xb_ld(&bar[XB_TMO])) break; if (sp > XB_SPIN_CAP) { atomicAdd(&bar[XB_TMO], 1u); break; } }
    }
    nloc = mine > 0u ? mine : 1u; nx = cnt > 0u ? cnt : 1u;
}

__device__ __forceinline__ void xcd_barrier(const XcdBarrier& b) {
    asm volatile("s_waitcnt vmcnt(0)" ::: "memory");
    __syncthreads();
    if (threadIdx.x == 0) {
        unsigned* bar = b.bar;
        __builtin_amdgcn_s_waitcnt(0);
        unsigned nloc = b.st[0], nx = b.st[1];
        if (nloc == 0u) { xcd_barrier_complete(bar, b.x, nloc, nx); b.st[0] = nloc; b.st[1] = nx; }
        const unsigned old = xb_add(&bar[XB_XSUB(b.x)], 1u);
        const unsigned gen = old / nloc;
        if (old + 1u == (gen + 1u) * nloc) {
            __builtin_amdgcn_fence(__ATOMIC_RELEASE, "agent");
            asm volatile("s_waitcnt vmcnt(0)" ::: "memory");
            const unsigned og = xb_add(&bar[XB_TOP], 1u);
            const unsigned tg = og / nx;
            if (og + 1u == (tg + 1u) * nx) xb_add(&bar[XB_TOPGEN], 1u);
            else XB_SPIN(xb_ld(&bar[XB_TOPGEN]) == tg, bar);
            __builtin_amdgcn_fence(__ATOMIC_ACQUIRE, "agent");
            xb_add(&bar[XB_XGEN(b.x)], 1u);
            asm volatile("s_waitcnt vmcnt(0)" ::: "memory");
        } else {
            XB_SPIN(xb_ld(&bar[XB_XGEN(b.x)]) == gen, bar);
            __builtin_amdgcn_fence(__ATOMIC_ACQUIRE, "agent");
            asm volatile("s_waitcnt vmcnt(0)" ::: "memory");
        }
    }
    __syncthreads();
}

typedef short bf16x8_t __attribute__((ext_vector_type(8)));
typedef float f32x16 __attribute__((ext_vector_type(16)));
#define MFMA32(a, b, c) __builtin_amdgcn_mfma_f32_32x32x16_bf16((a), (b), (c), 0, 0, 0)
typedef float f32x2_t __attribute__((ext_vector_type(2))); typedef __bf16 bf16x2_t __attribute__((ext_vector_type(2)));
__device__ __forceinline__ unsigned cvtpk(float lo, float hi) { f32x2_t v = {lo, hi}; bf16x2_t b = __builtin_convertvector(v, bf16x2_t); return __builtin_bit_cast(unsigned, b); }
constexpr int FOX_ROWB = 144, FOX_KB = 64 * FOX_ROWB, FOX_BUF = 2 * FOX_KB + 256;
template <int MODE>
__device__ __forceinline__ void fox_unit(const bf16* PROJ, const float* GATES, bf16* MIX, LAS unsigned char* lds, int b, int h, int qb, int tid, int lane, int wave) {
    constexpr float C2 = 0.125f * 1.4426950408889634f, L2E = 1.4426950408889634f;
    constexpr int NP = MODE == 0 ? NP1 : NP0, QC = MODE == 0 ? 1536 : 0, KC = MODE == 0 ? 2048 : 512, VC = MODE == 0 ? 2560 : 1024, OC = MODE == 0 ? 512 : 0;
    LAS float* biasl = (LAS float*)(lds + 2 * FOX_BUF);
    const int q = lane & 31, hi = lane >> 5;
    const size_t rowbase = (size_t)b * SEQ;
    const int q0 = qb * 256, qrow = q0 + wave * 32 + q;
    const int NT = 4 * qb + 4, T0 = MODE == 0 ? 0 : (4 * qb - 8 < 0 ? 0 : 4 * qb - 8);
    const bool isV = tid < 256;
    const int sidx = tid & 255, sr = sidx >> 3, sc = sidx & 7;
    const bf16* gK = PROJ + (rowbase + sr) * NP + KC + h * 64 + sc * 8;
    const bf16* gV = PROJ + (rowbase + 2 * sr) * NP + VC + h * 64 + sc * 8;
    const float* gF = GATES + (rowbase + tid) * 16 + 8 + h;
    u32x4 st0[2], st1[2]; float stf[2] = {0.f, 0.f};
#define FOX_LOAD(t, k) do { const size_t off = (size_t)(t) * 64 * NP; \
        if (isV) { st0[k] = *(const u32x4*)(gV + off); st1[k] = *(const u32x4*)(gV + off + NP); } \
        else { st0[k] = *(const u32x4*)(gK + off); st1[k] = *(const u32x4*)(gK + off + (size_t)32 * NP); } \
        if (MODE == 0 && tid < 64) stf[k] = gF[(size_t)(t) * 64 * 16]; } while (0)
#define FOX_STORE(buf, k) do { LAS unsigned char* B_ = lds + (buf) * FOX_BUF; const u32x4 A_ = st0[k], C_ = st1[k]; \
        if (isV) { LAS unsigned char* vt = B_ + FOX_KB + (8 * sc) * FOX_ROWB + 4 * sr; \
            *(LAS unsigned*)(vt + 0 * FOX_ROWB) = (A_.x & 0xffffu) | (C_.x << 16); *(LAS unsigned*)(vt + 1 * FOX_ROWB) = (A_.x >> 16) | (C_.x & 0xffff0000u); \
            *(LAS unsigned*)(vt + 2 * FOX_ROWB) = (A_.y & 0xffffu) | (C_.y << 16); *(LAS unsigned*)(vt + 3 * FOX_ROWB) = (A_.y >> 16) | (C_.y & 0xffff0000u); \
            *(LAS unsigned*)(vt + 4 * FOX_ROWB) = (A_.z & 0xffffu) | (C_.z << 16); *(LAS unsigned*)(vt + 5 * FOX_ROWB) = (A_.z >> 16) | (C_.z & 0xffff0000u); \
            *(LAS unsigned*)(vt + 6 * FOX_ROWB) = (A_.w & 0xffffu) | (C_.w << 16); *(LAS unsigned*)(vt + 7 * FOX_ROWB) = (A_.w >> 16) | (C_.w & 0xffff0000u); } \
        else { *(LAS u32x4*)(B_ + sr * FOX_ROWB + 16 * sc) = A_; *(LAS u32x4*)(B_ + (sr + 32) * FOX_ROWB + 16 * sc) = C_; } \
        if (MODE == 0 && tid < 64) *(LAS float*)(B_ + 2 * FOX_KB + 4 * tid) = -stf[k] * L2E; } while (0)
    FOX_LOAD(T0, 0);
    if (MODE == 1) { for (int i = tid; i < 513; i += NTHR) biasl[i] = GATES[h * 513 + i] * L2E; }
    bf16x8_t qr[4];
    { const bf16* qp = PROJ + (rowbase + qrow) * NP + QC + h * 64 + 8 * hi;
#pragma unroll
      for (int d0 = 0; d0 < 4; ++d0) qr[d0] = *(const bf16x8_t*)(qp + 16 * d0); }
    f32x16 o0, o1;
#pragma unroll
    for (int i = 0; i < 16; ++i) { o0[i] = 0.f; o1[i] = 0.f; }
    float m_ref = MODE == 0 ? -GATES[(rowbase + qrow) * 16 + 8 + h] * L2E : 0.f, l_run = 0.f;
    f32x16 negm;
#pragma unroll
    for (int i = 0; i < 16; ++i) negm[i] = -m_ref * (1.f / C2);
    FOX_STORE(T0 & 1, 0);
    FOX_LOAD(T0 + 1, 0); FOX_LOAD(T0 + 2, 1);
    LDS_BARRIER();
    const int nq = 4 * qb + (wave >> 1);
    bool fresh = true;
    for (int t2 = T0; t2 < NT; t2 += 2) {
#pragma unroll
      for (int k = 0; k < 2; ++k) {
        const int t = t2 + k;
        if (t < NT) {
        if (t + 1 < NT) FOX_STORE((t + 1) & 1, k);
        if (t + 3 < NT) FOX_LOAD(t + 3, k);
        const int s0 = t * 64;
        if (MODE == 0 ? (s0 <= q0 + wave * 32 + 31) : (t >= nq - 8 && t <= nq)) {
            const LAS unsigned char* Kl = lds + (t & 1) * FOX_BUF; const LAS unsigned char* Vl = Kl + FOX_KB; const LAS float* kbl = (const LAS float*)(Kl + 2 * FOX_KB);
            f32x16 p0, p1;
#pragma unroll
            for (int d0 = 0; d0 < 4; ++d0) {
                const bf16x8_t a0 = *(const LAS bf16x8_t*)(Kl + q * FOX_ROWB + (16 * d0 + 8 * hi) * 2);
                const bf16x8_t a1 = *(const LAS bf16x8_t*)(Kl + (32 + q) * FOX_ROWB + (16 * d0 + 8 * hi) * 2);
                if (d0 == 0) { p0 = MFMA32(a0, qr[0], negm); p1 = MFMA32(a1, qr[0], negm); }
                else { p0 = MFMA32(a0, qr[d0], p0); p1 = MFMA32(a1, qr[d0], p1); }
            }
            float mt = -INFINITY;
            const bool need_mask = (s0 + 63 > q0 + wave * 32);
#pragma unroll
            for (int g = 0; g < 4; ++g) {
                if (MODE == 0) {
                    const f32x4 k0 = *(const LAS f32x4*)(kbl + 8 * g + 4 * hi), k1 = *(const LAS f32x4*)(kbl + 32 + 8 * g + 4 * hi);
#pragma unroll
                    for (int j = 0; j < 4; ++j) {
                        float x0 = p0[4 * g + j] * C2 + k0[j], x1 = p1[4 * g + j] * C2 + k1[j];
                        if (need_mask) { const int kv = s0 + 8 * g + 4 * hi + j; if (kv > qrow) x0 = -INFINITY; if (kv + 32 > qrow) x1 = -INFINITY; }
                        p0[4 * g + j] = x0; p1[4 * g + j] = x1; mt = fmaxf(mt, fmaxf(x0, x1));
                    }
                } else if (t <= nq - 5) {
                    const float bc = biasl[512];
#pragma unroll
                    for (int j = 0; j < 4; ++j) {
                        const float x0 = p0[4 * g + j] * C2 + bc, x1 = p1[4 * g + j] * C2 + bc;
                        p0[4 * g + j] = x0; p1[4 * g + j] = x1; mt = fmaxf(mt, fmaxf(x0, x1));
                    }
                } else {
#pragma unroll
                    for (int j = 0; j < 4; ++j) {
                        int d0 = qrow - (s0 + 8 * g + 4 * hi + j) + 256, d1 = d0 - 32;
                        d0 = d0 < 0 ? 0 : (d0 > 512 ? 512 : d0); d1 = d1 < 0 ? 0 : (d1 > 512 ? 512 : d1);
                        const float x0 = p0[4 * g + j] * C2 + biasl[d0], x1 = p1[4 * g + j] * C2 + biasl[d1];
                        p0[4 * g + j] = x0; p1[4 * g + j] = x1; mt = fmaxf(mt, fmaxf(x0, x1));
                    }
                }
            }
            mt = fmaxf(mt, __shfl_xor(mt, 32));
            if (fresh) {
                fresh = false;
                const float dl = mt > -1e30f ? mt : 0.f;
                m_ref += dl;
#pragma unroll
                for (int i = 0; i < 16; ++i) { p0[i] -= dl; p1[i] -= dl; negm[i] = -m_ref * (1.f / C2); }
            } else if (__any(mt > 6.0f)) {
                const float dl = fmaxf(mt, 0.f), fac = __builtin_amdgcn_exp2f(-dl);
                m_ref += dl; l_run *= fac;
#pragma unroll
                for (int i = 0; i < 16; ++i) { p0[i] -= dl; p1[i] -= dl; o0[i] *= fac; o1[i] *= fac; negm[i] = -m_ref * (1.f / C2); }
            }
            float ls = 0.f;
#pragma unroll
            for (int i = 0; i < 16; ++i) { p0[i] = __builtin_amdgcn_exp2f(p0[i]); p1[i] = __builtin_amdgcn_exp2f(p1[i]); ls += p0[i] + p1[i]; }
            l_run += ls;
            bf16x8_t pf[4];
#pragma unroll
            for (int s = 0; s < 2; ++s) {
                u32x4 w; w.x = cvtpk(p0[8 * s], p0[8 * s + 1]); w.y = cvtpk(p0[8 * s + 2], p0[8 * s + 3]); w.z = cvtpk(p0[8 * s + 4], p0[8 * s + 5]); w.w = cvtpk(p0[8 * s + 6], p0[8 * s + 7]);
                pf[s] = __builtin_bit_cast(bf16x8_t, w);
                u32x4 w2; w2.x = cvtpk(p1[8 * s], p1[8 * s + 1]); w2.y = cvtpk(p1[8 * s + 2], p1[8 * s + 3]); w2.z = cvtpk(p1[8 * s + 4], p1[8 * s + 5]); w2.w = cvtpk(p1[8 * s + 6], p1[8 * s + 7]);
                pf[2 + s] = __builtin_bit_cast(bf16x8_t, w2);
            }
#pragma unroll
            for (int ks = 0; ks < 4; ++ks) {
                const LAS unsigned char* vp = Vl + q * FOX_ROWB + (16 * ks + 4 * hi) * 2;
                const u32x2 a = *(const LAS u32x2*)(vp), c = *(const LAS u32x2*)(vp + 16);
                const u32x2 a2 = *(const LAS u32x2*)(vp + 32 * FOX_ROWB), c2 = *(const LAS u32x2*)(vp + 32 * FOX_ROWB + 16);
                u32x4 v0; v0.x = a.x; v0.y = a.y; v0.z = c.x; v0.w = c.y;
                u32x4 v1; v1.x = a2.x; v1.y = a2.y; v1.z = c2.x; v1.w = c2.y;
                o0 = MFMA32(__builtin_bit_cast(bf16x8_t, v0), pf[ks], o0);
                o1 = MFMA32(__builtin_bit_cast(bf16x8_t, v1), pf[ks], o1);
            }
        }
        LDS_BARRIER();
        }
      }
    }
    l_run += __shfl_xor(l_run, 32);
    const float il = 1.f / l_run;
    bf16* op = MIX + (rowbase + qrow) * 1024 + OC + h * 64 + 4 * hi;
#pragma unroll
    for (int g = 0; g < 4; ++g) {
        u32x2 w; w.x = pk2(o0[4 * g] * il, o0[4 * g + 1] * il); w.y = pk2(o0[4 * g + 2] * il, o0[4 * g + 3] * il); *(u32x2*)(op + 8 * g) = w;
        u32x2 w2; w2.x = pk2(o1[4 * g] * il, o1[4 * g + 1] * il); w2.y = pk2(o1[4 * g + 2] * il, o1[4 * g + 3] * il); *(u32x2*)(op + 32 + 8 * g) = w2;
    }
#undef FOX_LOAD
#undef FOX_STORE
}

__device__ __forceinline__ void band_fast_phase(const bf16* PROJ, const float* relb, bf16* MIX, LAS unsigned char* lds, int bid, int b_lo, int G, int tid, int lane, int wave) {
    if (bid < b_lo) return;
    for (int u = bid - b_lo; u < 512; u += G - b_lo) {
        const int bh = u >> 5, qb = u & 31;
        fox_unit<1>(PROJ, relb, MIX, lds, bh >> 3, bh & 7, qb, tid, lane, wave);
    }
}


__device__ __forceinline__ void fox_unit_acp(const bf16* PROJ, const float* GATES, const unsigned* KN2, bf16* MIX, LAS unsigned char* lds, int b, int h, int qb, int tid, int lane, int wave) {
    constexpr float C2 = 0.125f * 1.4426950408889634f, L2E = 1.4426950408889634f;
    constexpr int NP = NP1, QC = 1536, KC = 2048, VC = 2560, OC = 512;
    LAS unsigned* votes = (LAS unsigned*)(lds + 2 * FOX_BUF);
    const int q = lane & 31, hi = lane >> 5;
    const size_t rowbase = (size_t)b * SEQ;
    const int q0 = qb * 256, qrow = q0 + wave * 32 + q;
    const int NT = 4 * qb + 4;
    const bool isV = tid < 256;
    const int sidx = tid & 255, sr = sidx >> 3, sc = sidx & 7;
    const bf16* gK = PROJ + (rowbase + sr) * NP + KC + h * 64 + sc * 8;
    const bf16* gV = PROJ + (rowbase + 2 * sr) * NP + VC + h * 64 + sc * 8;
    const float* gF = GATES + (rowbase + tid) * 16 + 8 + h;
    const float* Fh = GATES + rowbase * 16 + 8 + h;
    u32x4 st0, st1; float stf = 0.f;
#define ACP_LOAD(t) do { const size_t off = (size_t)(t) * 64 * NP; \
        if (isV) { st0 = *(const u32x4*)(gV + off); st1 = *(const u32x4*)(gV + off + NP); } \
        else { st0 = *(const u32x4*)(gK + off); st1 = *(const u32x4*)(gK + off + (size_t)32 * NP); } \
        if (tid < 64) stf = gF[(size_t)(t) * 64 * 16]; } while (0)
#define ACP_STORE(buf) do { LAS unsigned char* B_ = lds + (buf) * FOX_BUF; \
        if (isV) { LAS unsigned char* vt = B_ + FOX_KB + (8 * sc) * FOX_ROWB + 4 * sr; \
            *(LAS unsigned*)(vt + 0 * FOX_ROWB) = (st0.x & 0xffffu) | (st1.x << 16); *(LAS unsigned*)(vt + 1 * FOX_ROWB) = (st0.x >> 16) | (st1.x & 0xffff0000u); \
            *(LAS unsigned*)(vt + 2 * FOX_ROWB) = (st0.y & 0xffffu) | (st1.y << 16); *(LAS unsigned*)(vt + 3 * FOX_ROWB) = (st0.y >> 16) | (st1.y & 0xffff0000u); \
            *(LAS unsigned*)(vt + 4 * FOX_ROWB) = (st0.z & 0xffffu) | (st1.z << 16); *(LAS unsigned*)(vt + 5 * FOX_ROWB) = (st0.z >> 16) | (st1.z & 0xffff0000u); \
            *(LAS unsigned*)(vt + 6 * FOX_ROWB) = (st0.w & 0xffffu) | (st1.w << 16); *(LAS unsigned*)(vt + 7 * FOX_ROWB) = (st0.w >> 16) | (st1.w & 0xffff0000u); } \
        else { *(LAS u32x4*)(B_ + sr * FOX_ROWB + 16 * sc) = st0; *(LAS u32x4*)(B_ + (sr + 32) * FOX_ROWB + 16 * sc) = st1; } \
        if (tid < 64) *(LAS float*)(B_ + 2 * FOX_KB + 4 * tid) = -stf * L2E; } while (0)
    ACP_LOAD(NT - 1);
    bf16x8_t qr[4];
    { const bf16* qp = PROJ + (rowbase + qrow) * NP + QC + h * 64 + 8 * hi;
#pragma unroll
      for (int d0 = 0; d0 < 4; ++d0) qr[d0] = *(const bf16x8_t*)(qp + 16 * d0); }
    float qub;
    { float s2 = 0.f;
#pragma unroll
      for (int d0 = 0; d0 < 4; ++d0) { const u32x4 w = __builtin_bit_cast(u32x4, qr[d0]);
          s2 += bflo(w.x) * bflo(w.x) + bfhi(w.x) * bfhi(w.x) + bflo(w.y) * bflo(w.y) + bfhi(w.y) * bfhi(w.y) + bflo(w.z) * bflo(w.z) + bfhi(w.z) * bfhi(w.z) + bflo(w.w) * bflo(w.w) + bfhi(w.w) * bfhi(w.w); }
      s2 += __shfl_xor(s2, 32);
      qub = sqrtf(s2) * sqrtf(__uint_as_float(KN2[b * 8 + h])) * C2 * 1.01f + 0.01f; }
    const float Ft2 = GATES[(rowbase + qrow) * 16 + 8 + h] * L2E;
    f32x16 o0, o1;
#pragma unroll
    for (int i = 0; i < 16; ++i) { o0[i] = 0.f; o1[i] = 0.f; }
    float m_ref = -Ft2, l_run = 0.f, mrow = -INFINITY;
    f32x16 negm;
#pragma unroll
    for (int i = 0; i < 16; ++i) negm[i] = -m_ref * (1.f / C2);
    ACP_STORE(0);
    LDS_BARRIER();
    int it = 0; bool fresh = true;
    for (int t = NT - 1; t >= 0; --t, ++it) {
        float Fnext = 0.f;
        if (t > 0) { ACP_LOAD(t - 1); Fnext = Fh[(size_t)((t - 1) * 64 + 63) * 16]; }
        const int s0 = t * 64;
        if (s0 <= q0 + wave * 32 + 31) {
            const LAS unsigned char* Kl = lds + (it & 1) * FOX_BUF; const LAS unsigned char* Vl = Kl + FOX_KB; const LAS float* kbl = (const LAS float*)(Kl + 2 * FOX_KB);
            f32x16 p0, p1;
#pragma unroll
            for (int d0 = 0; d0 < 4; ++d0) {
                const bf16x8_t a0 = *(const LAS bf16x8_t*)(Kl + q * FOX_ROWB + (16 * d0 + 8 * hi) * 2);
                const bf16x8_t a1 = *(const LAS bf16x8_t*)(Kl + (32 + q) * FOX_ROWB + (16 * d0 + 8 * hi) * 2);
                if (d0 == 0) { p0 = MFMA32(a0, qr[0], negm); p1 = MFMA32(a1, qr[0], negm); }
                else { p0 = MFMA32(a0, qr[d0], p0); p1 = MFMA32(a1, qr[d0], p1); }
            }
            float mt = -INFINITY;
            const bool need_mask = (s0 + 63 > q0 + wave * 32);
#pragma unroll
            for (int g = 0; g < 4; ++g) {
                const f32x4 k0 = *(const LAS f32x4*)(kbl + 8 * g + 4 * hi), k1 = *(const LAS f32x4*)(kbl + 32 + 8 * g + 4 * hi);
#pragma unroll
                for (int j = 0; j < 4; ++j) {
                    float x0 = p0[4 * g + j] * C2 + k0[j], x1 = p1[4 * g + j] * C2 + k1[j];
                    if (need_mask) { const int kv = s0 + 8 * g + 4 * hi + j; if (kv > qrow) x0 = -INFINITY; if (kv + 32 > qrow) x1 = -INFINITY; }
                    p0[4 * g + j] = x0; p1[4 * g + j] = x1; mt = fmaxf(mt, fmaxf(x0, x1));
                }
            }
            mt = fmaxf(mt, __shfl_xor(mt, 32));
            mrow = fmaxf(mrow, mt);
            if (fresh) {
                fresh = false;
                const float dl = mt > -1e30f ? mt : 0.f;
                m_ref += dl; mrow -= dl;
#pragma unroll
                for (int i = 0; i < 16; ++i) { p0[i] -= dl; p1[i] -= dl; negm[i] = -m_ref * (1.f / C2); }
            } else if (__any(mt > 6.0f)) {
                const float dl = fmaxf(mt, 0.f), fac = __builtin_amdgcn_exp2f(-dl);
                m_ref += dl; l_run *= fac; mrow -= dl;
#pragma unroll
                for (int i = 0; i < 16; ++i) { p0[i] -= dl; p1[i] -= dl; o0[i] *= fac; o1[i] *= fac; negm[i] = -m_ref * (1.f / C2); }
            }
            float ls = 0.f;
#pragma unroll
            for (int i = 0; i < 16; ++i) { p0[i] = __builtin_amdgcn_exp2f(p0[i]); p1[i] = __builtin_amdgcn_exp2f(p1[i]); ls += p0[i] + p1[i]; }
            l_run += ls;
            bf16x8_t pf[4];
#pragma unroll
            for (int s = 0; s < 2; ++s) {
                u32x4 w; w.x = cvtpk(p0[8 * s], p0[8 * s + 1]); w.y = cvtpk(p0[8 * s + 2], p0[8 * s + 3]); w.z = cvtpk(p0[8 * s + 4], p0[8 * s + 5]); w.w = cvtpk(p0[8 * s + 6], p0[8 * s + 7]);
                pf[s] = __builtin_bit_cast(bf16x8_t, w);
                u32x4 w2; w2.x = cvtpk(p1[8 * s], p1[8 * s + 1]); w2.y = cvtpk(p1[8 * s + 2], p1[8 * s + 3]); w2.z = cvtpk(p1[8 * s + 4], p1[8 * s + 5]); w2.w = cvtpk(p1[8 * s + 6], p1[8 * s + 7]);
                pf[2 + s] = __builtin_bit_cast(bf16x8_t, w2);
            }
#pragma unroll
            for (int ks = 0; ks < 4; ++ks) {
                const LAS unsigned char* vp = Vl + q * FOX_ROWB + (16 * ks + 4 * hi) * 2;
                const u32x2 a = *(const LAS u32x2*)(vp), c = *(const LAS u32x2*)(vp + 16);
                const u32x2 a2 = *(const LAS u32x2*)(vp + 32 * FOX_ROWB), c2 = *(const LAS u32x2*)(vp + 32 * FOX_ROWB + 16);
                u32x4 v0; v0.x = a.x; v0.y = a.y; v0.z = c.x; v0.w = c.y;
                u32x4 v1; v1.x = a2.x; v1.y = a2.y; v1.z = c2.x; v1.w = c2.y;
                o0 = MFMA32(__builtin_bit_cast(bf16x8_t, v0), pf[ks], o0);
                o1 = MFMA32(__builtin_bit_cast(bf16x8_t, v1), pf[ks], o1);
            }
        }
        if (t == 0) break;
        { const float xub = qub - Fnext * L2E - m_ref;
          const bool drop = xub < mrow - 40.0f;
          const unsigned v = __all(drop) ? 1u : 0u;
          if (lane == 0) votes[(it & 1) * 8 + wave] = v; }
        ACP_STORE((it + 1) & 1);
        LDS_BARRIER();
        { const LAS unsigned* vv = votes + (it & 1) * 8;
          const unsigned all = vv[0] & vv[1] & vv[2] & vv[3] & vv[4] & vv[5] & vv[6] & vv[7];
          if (all) break; }
    }
    LDS_BARRIER();
    l_run += __shfl_xor(l_run, 32);
    const float il = 1.f / l_run;
    bf16* op = MIX + (rowbase + qrow) * 1024 + OC + h * 64 + 4 * hi;
#pragma unroll
    for (int g = 0; g < 4; ++g) {
        u32x2 w; w.x = pk2(o0[4 * g] * il, o0[4 * g + 1] * il); w.y = pk2(o0[4 * g + 2] * il, o0[4 * g + 3] * il); *(u32x2*)(op + 8 * g) = w;
        u32x2 w2; w2.x = pk2(o1[4 * g] * il, o1[4 * g + 1] * il); w2.y = pk2(o1[4 * g + 2] * il, o1[4 * g + 3] * il); *(u32x2*)(op + 32 + 8 * g) = w2;
    }
#undef ACP_LOAD
#undef ACP_STORE
}
__device__ __forceinline__ void fox_acp_phase(const bf16* PROJ, const float* GATES, const unsigned* KN2, bf16* MIX, LAS unsigned char* lds, int bid, int G, int tid, int lane, int wave) {
    for (int u = bid; u < 512; u += G) {
        const int bh = u & 15, qb = 31 - (u >> 4);
        fox_unit_acp(PROJ, GATES, KN2, MIX, lds, bh >> 3, bh & 7, qb, tid, lane, wave);
    }
}

constexpr int SSD_ROWB = 144, SSD_XT = 512 * SSD_ROWB, SSD_BT = 256 * SSD_ROWB;
__device__ __forceinline__ float wave_incl_scan(float v, int lane) {
#pragma unroll
    for (int o = 1; o < 64; o <<= 1) { const float t = __shfl_up(v, o); if (lane >= o) v += t; }
    return v;
}
__device__ __forceinline__ void ssd_states_phase(const bf16* PROJ, const float* convw, const float* convb, bf16* XBC, const float* GATES, const float* a_log, bf16* ST, float* DEC, unsigned* KN2,
                                                 LAS unsigned char* lds, int bid, int G, int tid, int lane, int wave) {
    LAS unsigned char* xwT = lds; LAS unsigned char* BT = lds + SSD_XT; LAS float* wl = (LAS float*)(lds + SSD_XT + SSD_BT);
    const int h = wave, g = h >> 2, q = lane & 31, hi = lane >> 5;
    const float a = -__expf(a_log[h]);
    for (int ch = bid; ch < 256; ch += G) {
        const size_t m0 = (size_t)ch * 64;
        const int t0c = (ch & 127) * 64;
        { const float dtl = GATES[(m0 + lane) * 16 + h]; const float v = wave_incl_scan(dtl * a, lane); const float tot = __shfl(v, 63);
          wl[h * 64 + lane] = __expf(tot - v) * dtl; if (lane == 63) DEC[ch * 8 + h] = __expf(tot); }
        {
            const int r = tid >> 3, hh = tid & 7; const u32x4* kp = (const u32x4*)(PROJ + (m0 + r) * NP1 + 2048 + hh * 64); float s2 = 0.f;
#pragma unroll
            for (int i = 0; i < 8; ++i) { const u32x4 w = kp[i]; s2 += bflo(w.x) * bflo(w.x) + bfhi(w.x) * bfhi(w.x) + bflo(w.y) * bflo(w.y) + bfhi(w.y) * bfhi(w.y) + bflo(w.z) * bflo(w.z) + bfhi(w.z) * bfhi(w.z) + bflo(w.w) * bflo(w.w) + bfhi(w.w) * bfhi(w.w); }
            s2 = fmaxf(s2, __shfl_xor(s2, 8)); s2 = fmaxf(s2, __shfl_xor(s2, 16)); s2 = fmaxf(s2, __shfl_xor(s2, 32));
            if (lane < 8) wl[512 + wave * 8 + hh] = s2; }
        __syncthreads();
        if (tid < 8) {
            float m8 = wl[512 + tid];
#pragma unroll
            for (int w = 1; w < 8; ++w) m8 = fmaxf(m8, wl[512 + w * 8 + tid]);
            unsigned* kp = KN2 + (ch >> 7) * 8 + tid; const unsigned bits = __float_as_uint(m8);
            if (__hip_atomic_load(kp, __ATOMIC_RELAXED, __HIP_MEMORY_SCOPE_AGENT) < bits) atomicMax(kp, bits);
        }
#pragma unroll 1
        for (int k = 0; k < 2; ++k) {
            const int blk = tid + NTHR * k, rb8 = blk >> 7, cg = blk & 127, c0 = 8 * cg;
            const bf16* src = PROJ + (m0 + 8 * rb8) * NP1 + 512 + c0;
            u32x4 xr[11];
#pragma unroll
            for (int r = 0; r < 11; ++r) { if (t0c + 8 * rb8 + r - 3 >= 0) xr[r] = *(const u32x4*)(src + (ptrdiff_t)(r - 3) * NP1); else xr[r] = (u32x4){0u, 0u, 0u, 0u}; }
            float w[4][8], bb[8];
#pragma unroll
            for (int j = 0; j < 4; ++j) { const f32x4 aa = *(const f32x4*)(convw + j * 1024 + c0), cc = *(const f32x4*)(convw + j * 1024 + c0 + 4);
                w[j][0] = aa.x; w[j][1] = aa.y; w[j][2] = aa.z; w[j][3] = aa.w; w[j][4] = cc.x; w[j][5] = cc.y; w[j][6] = cc.z; w[j][7] = cc.w; }
            { const f32x4 aa = *(const f32x4*)(convb + c0), cc = *(const f32x4*)(convb + c0 + 4); bb[0] = aa.x; bb[1] = aa.y; bb[2] = aa.z; bb[3] = aa.w; bb[4] = cc.x; bb[5] = cc.y; bb[6] = cc.z; bb[7] = cc.w; }
#pragma unroll
            for (int pr = 0; pr < 4; ++pr) {
                float v0[8], v1[8], f[8];
#pragma unroll
                for (int i = 0; i < 8; ++i) { v0[i] = bb[i]; v1[i] = bb[i]; }
#pragma unroll
                for (int j = 0; j < 4; ++j) { unpack8(xr[2 * pr + j], f);
#pragma unroll
                    for (int i = 0; i < 8; ++i) v0[i] += w[j][i] * f[i];
                    unpack8(xr[2 * pr + 1 + j], f);
#pragma unroll
                    for (int i = 0; i < 8; ++i) v1[i] += w[j][i] * f[i]; }
#pragma unroll
                for (int i = 0; i < 8; ++i) { v0[i] = silu_f(v0[i]); v1[i] = silu_f(v1[i]); }
                const int r0 = 8 * rb8 + 2 * pr;
                u32x4 o0; o0.x = pk2(v0[0], v0[1]); o0.y = pk2(v0[2], v0[3]); o0.z = pk2(v0[4], v0[5]); o0.w = pk2(v0[6], v0[7]);
                u32x4 o1; o1.x = pk2(v1[0], v1[1]); o1.y = pk2(v1[2], v1[3]); o1.z = pk2(v1[4], v1[5]); o1.w = pk2(v1[6], v1[7]);
                *(u32x4*)(XBC + (m0 + r0) * 1024 + c0) = o0; *(u32x4*)(XBC + (m0 + r0 + 1) * 1024 + c0) = o1;
                if (cg < 64) {
                    const int hh = cg >> 3; const float w0 = wl[hh * 64 + r0], w1 = wl[hh * 64 + r0 + 1];
                    LAS unsigned char* d = xwT + c0 * SSD_ROWB + 2 * r0;
                    *(LAS unsigned*)(d + 0 * SSD_ROWB) = pk2(bflo(o0.x) * w0, bflo(o1.x) * w1); *(LAS unsigned*)(d + 1 * SSD_ROWB) = pk2(bfhi(o0.x) * w0, bfhi(o1.x) * w1);
                    *(LAS unsigned*)(d + 2 * SSD_ROWB) = pk2(bflo(o0.y) * w0, bflo(o1.y) * w1); *(LAS unsigned*)(d + 3 * SSD_ROWB) = pk2(bfhi(o0.y) * w0, bfhi(o1.y) * w1);
                    *(LAS unsigned*)(d + 4 * SSD_ROWB) = pk2(bflo(o0.z) * w0, bflo(o1.z) * w1); *(LAS unsigned*)(d + 5 * SSD_ROWB) = pk2(bfhi(o0.z) * w0, bfhi(o1.z) * w1);
                    *(LAS unsigned*)(d + 6 * SSD_ROWB) = pk2(bflo(o0.w) * w0, bflo(o1.w) * w1); *(LAS unsigned*)(d + 7 * SSD_ROWB) = pk2(bfhi(o0.w) * w0, bfhi(o1.w) * w1);
                } else if (cg < 96) {
                    LAS unsigned char* d = BT + (c0 - 512) * SSD_ROWB + 2 * r0;
                    *(LAS unsigned*)(d + 0 * SSD_ROWB) = (o0.x & 0xffffu) | (o1.x << 16); *(LAS unsigned*)(d + 1 * SSD_ROWB) = (o0.x >> 16) | (o1.x & 0xffff0000u);
                    *(LAS unsigned*)(d + 2 * SSD_ROWB) = (o0.y & 0xffffu) | (o1.y << 16); *(LAS unsigned*)(d + 3 * SSD_ROWB) = (o0.y >> 16) | (o1.y & 0xffff0000u);
                    *(LAS unsigned*)(d + 4 * SSD_ROWB) = (o0.z & 0xffffu) | (o1.z << 16); *(LAS unsigned*)(d + 5 * SSD_ROWB) = (o0.z >> 16) | (o1.z & 0xffff0000u);
                    *(LAS unsigned*)(d + 6 * SSD_ROWB) = (o0.w & 0xffffu) | (o1.w << 16); *(LAS unsigned*)(d + 7 * SSD_ROWB) = (o0.w >> 16) | (o1.w & 0xffff0000u);
                }
            }
        }
        __syncthreads();
        bf16* stb = ST + ((size_t)(ch * 8 + h) * 64) * 128;
#pragma unroll
        for (int nb = 0; nb < 4; ++nb)
#pragma unroll
            for (int pb = 0; pb < 2; ++pb) {
                f32x16 acc;
#pragma unroll
                for (int i = 0; i < 16; ++i) acc[i] = 0.f;
#pragma unroll
                for (int ks = 0; ks < 4; ++ks) {
                    const bf16x8_t af = *(const LAS bf16x8_t*)(BT + (g * 128 + 32 * nb + q) * SSD_ROWB + (16 * ks + 8 * hi) * 2);
                    const bf16x8_t bfr = *(const LAS bf16x8_t*)(xwT + (h * 64 + 32 * pb + q) * SSD_ROWB + (16 * ks + 8 * hi) * 2);
                    acc = MFMA32(af, bfr, acc);
                }
                bf16* o = stb + (size_t)(32 * pb + q) * 128 + 32 * nb + 4 * hi;
#pragma unroll
                for (int g4 = 0; g4 < 4; ++g4) { u32x2 w; w.x = cvtpk(acc[4 * g4], acc[4 * g4 + 1]); w.y = cvtpk(acc[4 * g4 + 2], acc[4 * g4 + 3]); *(u32x2*)(o + 8 * g4) = w; }
            }
        __syncthreads();
    }
}
__device__ __forceinline__ void ssd_scan_phase(bf16* ST, const float* DEC, int bid, int G, int tid) {
    for (int e = bid * NTHR + tid; e < 65536; e += G * NTHR) {
        const int b = e >> 15, rem = e & 32767, h = rem >> 12;
        unsigned* base = (unsigned*)(ST + (size_t)b * 128 * 65536 + (size_t)rem * 2);
        const float* dec = DEC + (size_t)b * 128 * 8 + h;
        float r0 = 0.f, r1 = 0.f;
        for (int c0 = 0; c0 < 128; c0 += 8) {
            unsigned s[8]; float dc[8];
#pragma unroll
            for (int j = 0; j < 8; ++j) { s[j] = base[(size_t)(c0 + j) * 32768]; dc[j] = dec[(c0 + j) * 8]; }
#pragma unroll
            for (int j = 0; j < 8; ++j) { base[(size_t)(c0 + j) * 32768] = pk2(r0, r1); r0 = r0 * dc[j] + bflo(s[j]); r1 = r1 * dc[j] + bfhi(s[j]); }
        }
    }
}
__device__ __forceinline__ void ssd_out_phase(const bf16* XBC, const bf16* PROJ, const float* GATES, const float* a_log, const float* d_skip, const float* nw,
                                              const bf16* ST, bf16* MIX, LAS unsigned char* lds, int bid, int G, int tid, int lane, int wave) {
    LAS unsigned char* xT = lds; LAS float* dal = (LAS float*)(lds + SSD_XT); LAS float* dtl_ = dal + 512; LAS float* red = dtl_ + 512;
    const int h = wave, g = h >> 2, q = lane & 31, hi = lane >> 5;
    const float a = -__expf(a_log[h]), dsk = d_skip[h];
    for (int ch = bid; ch < 256; ch += G) {
        const size_t m0 = (size_t)ch * 64;
        { const float dtl = GATES[(m0 + lane) * 16 + h]; const float v = wave_incl_scan(dtl * a, lane); dal[h * 64 + lane] = v; dtl_[h * 64 + lane] = dtl; }
#pragma unroll
        for (int k = 0; k < 4; ++k) {
            const int u = tid + NTHR * k, rp = u >> 6, cc = u & 63;
            const bf16* src = XBC + (m0 + 2 * rp) * 1024 + 8 * cc;
            const u32x4 s0 = *(const u32x4*)src, s1 = *(const u32x4*)(src + 1024);
            LAS unsigned char* d = xT + (8 * cc) * SSD_ROWB + 4 * rp;
            *(LAS unsigned*)(d + 0 * SSD_ROWB) = (s0.x & 0xffffu) | (s1.x << 16); *(LAS unsigned*)(d + 1 * SSD_ROWB) = (s0.x >> 16) | (s1.x & 0xffff0000u);
            *(LAS unsigned*)(d + 2 * SSD_ROWB) = (s0.y & 0xffffu) | (s1.y << 16); *(LAS unsigned*)(d + 3 * SSD_ROWB) = (s0.y >> 16) | (s1.y & 0xffff0000u);
            *(LAS unsigned*)(d + 4 * SSD_ROWB) = (s0.z & 0xffffu) | (s1.z << 16); *(LAS unsigned*)(d + 5 * SSD_ROWB) = (s0.z >> 16) | (s1.z & 0xffff0000u);
            *(LAS unsigned*)(d + 6 * SSD_ROWB) = (s0.w & 0xffffu) | (s1.w << 16); *(LAS unsigned*)(d + 7 * SSD_ROWB) = (s0.w >> 16) | (s1.w & 0xffff0000u);
        }
        __syncthreads();
        const bf16* Bg = XBC + (m0 + q) * 1024 + 512 + g * 128 + 8 * hi;
#pragma unroll 1
        for (int lb = 0; lb < 2; ++lb) {
            const int l = 32 * lb + q; const size_t m = m0 + l;
            const bf16* Cg = XBC + m * 1024 + 768 + g * 128 + 8 * hi;
            const float dl = dal[h * 64 + l];
            bf16x8_t wf[2][2];
            bf16x8_t fc[8];
            {
                f32x16 cb[2];
#pragma unroll
                for (int i = 0; i < 16; ++i) { cb[0][i] = 0.f; cb[1][i] = 0.f; }
                bf16x8_t fb0[8], fb1[8];
#pragma unroll
                for (int ks = 0; ks < 8; ++ks) { fb0[ks] = *(const bf16x8_t*)(Bg + 16 * ks); fb1[ks] = *(const bf16x8_t*)(Bg + 32 * 1024 + 16 * ks); fc[ks] = *(const bf16x8_t*)(Cg + 16 * ks); }
                asm volatile("" ::: "memory");
#pragma unroll
                for (int ks = 0; ks < 8; ++ks) { cb[0] = MFMA32(fb0[ks], fc[ks], cb[0]); cb[1] = MFMA32(fb1[ks], fc[ks], cb[1]); }
#pragma unroll
                for (int sb = 0; sb < 2; ++sb) {
#pragma unroll
                    for (int g4 = 0; g4 < 4; ++g4) {
                        const int s = 32 * sb + 8 * g4 + 4 * hi;
                        const f32x4 ds4 = *(const LAS f32x4*)(dal + h * 64 + s), dt4 = *(const LAS f32x4*)(dtl_ + h * 64 + s);
#pragma unroll
                        for (int j = 0; j < 4; ++j) { const float v = cb[sb][4 * g4 + j] * __expf(fminf(dl - ds4[j], 0.f)) * dt4[j]; cb[sb][4 * g4 + j] = (s + j <= l) ? v : 0.f; }
                    }
#pragma unroll
                    for (int s2 = 0; s2 < 2; ++s2) { u32x4 w; w.x = cvtpk(cb[sb][8 * s2], cb[sb][8 * s2 + 1]); w.y = cvtpk(cb[sb][8 * s2 + 2], cb[sb][8 * s2 + 3]);
                        w.z = cvtpk(cb[sb][8 * s2 + 4], cb[sb][8 * s2 + 5]); w.w = cvtpk(cb[sb][8 * s2 + 6], cb[sb][8 * s2 + 7]); wf[sb][s2] = __builtin_bit_cast(bf16x8_t, w); }
                }
            }
            f32x16 y[2];
#pragma unroll
            for (int i = 0; i < 16; ++i) { y[0][i] = 0.f; y[1][i] = 0.f; }
#pragma unroll
            for (int sb = 0; sb < 2; ++sb)
#pragma unroll
                for (int s2 = 0; s2 < 2; ++s2)
#pragma unroll
                    for (int pb = 0; pb < 2; ++pb) {
                        const LAS unsigned char* xp = xT + (h * 64 + 32 * pb + q) * SSD_ROWB + (32 * sb + 16 * s2 + 4 * hi) * 2;
                        const u32x2 x0 = *(const LAS u32x2*)xp, x1 = *(const LAS u32x2*)(xp + 16);
                        u32x4 xa; xa.x = x0.x; xa.y = x0.y; xa.z = x1.x; xa.w = x1.y;
                        y[pb] = MFMA32(__builtin_bit_cast(bf16x8_t, xa), wf[sb][s2], y[pb]);
                    }
            {
                f32x16 yo[2];
#pragma unroll
                for (int i = 0; i < 16; ++i) { yo[0][i] = 0.f; yo[1][i] = 0.f; }
                const bf16* Pg = ST + ((size_t)(ch * 8 + h) * 64 + q) * 128 + 8 * hi;
                bf16x8_t fp0[8], fp1[8];
#pragma unroll
                for (int ks = 0; ks < 8; ++ks) { fp0[ks] = *(const bf16x8_t*)(Pg + 16 * ks); fp1[ks] = *(const bf16x8_t*)(Pg + 32 * 128 + 16 * ks); }
                asm volatile("" ::: "memory");
#pragma unroll
                for (int ks = 0; ks < 8; ++ks) { yo[0] = MFMA32(fp0[ks], fc[ks], yo[0]); yo[1] = MFMA32(fp1[ks], fc[ks], yo[1]); }
                const float el = __expf(dl);
#pragma unroll
                for (int pb = 0; pb < 2; ++pb)
#pragma unroll
                    for (int i = 0; i < 16; ++i) y[pb][i] += el * yo[pb][i];
            }
            float ss = 0.f;
#pragma unroll
            for (int pb = 0; pb < 2; ++pb)
#pragma unroll
                for (int g4 = 0; g4 < 4; ++g4) {
                    const int pcol = h * 64 + 32 * pb + 8 * g4 + 4 * hi;
                    const u32x2 xw = *(const u32x2*)(XBC + m * 1024 + pcol), zw = *(const u32x2*)(PROJ + m * NP1 + pcol);
                    float v0 = (y[pb][4 * g4] + dsk * bflo(xw.x)) * silu_f(bflo(zw.x)), v1 = (y[pb][4 * g4 + 1] + dsk * bfhi(xw.x)) * silu_f(bfhi(zw.x));
                    float v2 = (y[pb][4 * g4 + 2] + dsk * bflo(xw.y)) * silu_f(bflo(zw.y)), v3 = (y[pb][4 * g4 + 3] + dsk * bfhi(xw.y)) * silu_f(bfhi(zw.y));
                    y[pb][4 * g4] = v0; y[pb][4 * g4 + 1] = v1; y[pb][4 * g4 + 2] = v2; y[pb][4 * g4 + 3] = v3;
                    ss += (v0 * v0 + v1 * v1) + (v2 * v2 + v3 * v3);
                }
            ss += __shfl_xor(ss, 32);
            if (hi == 0) red[h * 64 + l] = ss;
            __syncthreads();
            const float tot = (red[(4 * g) * 64 + l] + red[(4 * g + 1) * 64 + l]) + (red[(4 * g + 2) * 64 + l] + red[(4 * g + 3) * 64 + l]);
            const float rs = rsqrtf(tot * (1.f / 256.f) + 1e-6f);
#pragma unroll
            for (int pb = 0; pb < 2; ++pb)
#pragma unroll
                for (int g4 = 0; g4 < 4; ++g4) {
                    const int pcol = h * 64 + 32 * pb + 8 * g4 + 4 * hi;
                    const f32x4 w4 = *(const f32x4*)(nw + pcol);
                    u32x2 o; o.x = pk2(y[pb][4 * g4] * rs * w4.x, y[pb][4 * g4 + 1] * rs * w4.y); o.y = pk2(y[pb][4 * g4 + 2] * rs * w4.z, y[pb][4 * g4 + 3] * rs * w4.w);
                    *(u32x2*)(MIX + m * 1024 + pcol) = o;
                }
        }
        __syncthreads();
    }
}

constexpr int DFR_UNIT = 57344, DFR_NW = 0, DFR_QD = 16384, DFR_KST = 32768, DFR_ATT = 49152, DU_UNIT = 8192;
constexpr int DL_A = 0, DL_AT = 16384, DL_NW = 25600, DL_GC = 43008, DL_BETA = 43264;
__device__ __forceinline__ bf16x8_t pack8(const f32x16& x, int s) {
    u32x4 w; w.x = cvtpk(x[8 * s], x[8 * s + 1]); w.y = cvtpk(x[8 * s + 2], x[8 * s + 3]); w.z = cvtpk(x[8 * s + 4], x[8 * s + 5]); w.w = cvtpk(x[8 * s + 6], x[8 * s + 7]);
    return __builtin_bit_cast(bf16x8_t, w);
}
__device__ __forceinline__ void delta_prep_phase(const bf16* QK, const bf16* VB, const float* GATES, unsigned char* FR, unsigned char* U0, unsigned char* U1, float* GL,
                                                 LAS unsigned char* lds, int bid, int G, int tid, int lane, int wave) {
    const int half = wave >> 2, w4 = wave & 3, t4 = tid & 255;
    LAS unsigned char* lb = lds + half * 45056;
    LAS float* Al = (LAS float*)(lb + DL_A); LAS unsigned char* ATl = lb + DL_AT; LAS unsigned char* NWl = lb + DL_NW;
    LAS float* gcl = (LAS float*)(lb + DL_GC); LAS float* betal = (LAS float*)(lb + DL_BETA);
    const int q = lane & 31, hi = lane >> 5;
    for (int pair = bid; pair < 512; pair += G) {
        const int unit = (pair & 7) * 128 + (pair >> 3) * 2 + half;
        const int bh = unit >> 7, c = unit & 127, b = bh >> 2, h = bh & 3;
        const size_t m0 = (size_t)b * SEQ + c * 64;
        unsigned char* FRu = FR + (size_t)unit * DFR_UNIT;
        if (w4 == 0) { const float gc = wave_incl_scan(GATES[(m0 + lane) * 16 + 4 + h], lane); gcl[lane] = gc; betal[lane] = GATES[(m0 + lane) * 16 + h]; if (lane == 63) GL[unit] = __expf(gc); }
        __syncthreads();
#pragma unroll 1
        for (int bb = 0; bb < 2; ++bb) {
            const int ib = w4 >> 1, jb = w4 & 1;
            const bf16* Ar = QK + (m0 + 32 * ib + q) * 1024 + (bb == 0 ? 512 : 0) + h * 128 + 8 * hi;
            const bf16* Br = QK + (m0 + 32 * jb + q) * 1024 + 512 + h * 128 + 8 * hi;
            f32x16 acc;
#pragma unroll
            for (int i = 0; i < 16; ++i) acc[i] = 0.f;
            bf16x8_t fa[8], fb[8];
#pragma unroll
            for (int ks = 0; ks < 8; ++ks) { fa[ks] = *(const bf16x8_t*)(Ar + 16 * ks); fb[ks] = *(const bf16x8_t*)(Br + 16 * ks); }
            asm volatile("" ::: "memory");
#pragma unroll
            for (int ks = 0; ks < 8; ++ks) acc = MFMA32(fa[ks], fb[ks], acc);
            const int j = 32 * jb + q; const float gj = gcl[j];
#pragma unroll
            for (int g4 = 0; g4 < 4; ++g4) {
                const int i0 = 32 * ib + 8 * g4 + 4 * hi;
                const f32x4 gi4 = *(const LAS f32x4*)(gcl + i0), bi4 = *(const LAS f32x4*)(betal + i0);
#pragma unroll
                for (int r = 0; r < 4; ++r) {
                    const int i = i0 + r; const float e = __expf(fminf(gi4[r] - gj, 0.f));
                    if (bb == 0) Al[i * 64 + j] = (j < i) ? bi4[r] * acc[4 * g4 + r] * e : 0.f;
                    else *(LAS unsigned short*)(ATl + i * 144 + j * 2) = (unsigned short)f2bf((j <= i) ? acc[4 * g4 + r] * e : 0.f);
                }
            }
        }
        __syncthreads();
        {
            float x[64];
            if (t4 < 128) {
#pragma unroll
                for (int i = 0; i < 64; ++i) x[i] = bf2f(VB[(m0 + i) * 512 + h * 128 + t4]) * betal[i];
            } else {
#pragma unroll
                for (int i = 0; i < 64; ++i) x[i] = bf2f(QK[(m0 + i) * 1024 + 512 + h * 128 + (t4 - 128)]) * betal[i] * __expf(gcl[i]);
            }
#pragma unroll
            for (int i = 1; i < 64; ++i) {
                float r = x[i];
#pragma unroll
                for (int j4 = 0; j4 <= (i - 1) / 4; ++j4) { const f32x4 a4 = *(const LAS f32x4*)(Al + i * 64 + 4 * j4);
                    r -= a4.x * x[4 * j4]; if (4 * j4 + 1 < i) r -= a4.y * x[4 * j4 + 1]; if (4 * j4 + 2 < i) r -= a4.z * x[4 * j4 + 2]; if (4 * j4 + 3 < i) r -= a4.w * x[4 * j4 + 3]; }
                x[i] = r;
            }
            if (t4 < 128) {
                const int sl = t4 >> 4, col = t4 & 15;
#pragma unroll
                for (int rt = 0; rt < 4; ++rt) { unsigned char* Ub = ((rt >> 1) == 0 ? U0 : U1) + (size_t)unit * DU_UNIT;
#pragma unroll
                    for (int qd = 0; qd < 4; ++qd) { const int i0 = 16 * rt + 4 * qd; u32x2 w; w.x = pk2(x[i0], x[i0 + 1]); w.y = pk2(x[i0 + 2], x[i0 + 3]);
                        *(u32x2*)(Ub + (((sl * 2 + (rt & 1)) * 64 + qd * 16 + col) * 8)) = w; } }
            } else {
                const int dd = t4 - 128;
#pragma unroll
                for (int i = 0; i < 64; ++i) *(LAS unsigned short*)(NWl + i * 272 + dd * 2) = (unsigned short)f2bf(-x[i]);
            }
        }
        {
            const float gl = gcl[63];
#pragma unroll
            for (int k = 0; k < 4; ++k) {
                const int it = t4 + 256 * k, f = it >> 6, ln = it & 63, rt = f >> 2, ks = f & 3, i = 16 * rt + (ln & 15), qd = ln >> 4;
                const bf16* src = QK + (m0 + i) * 1024 + h * 128 + 32 * ks + 4 * qd; const float e = __expf(gcl[i]);
                const u32x2 a = *(const u32x2*)src, c2 = *(const u32x2*)(src + 16);
                u32x4 w; w.x = pk2(bflo(a.x) * e, bfhi(a.x) * e); w.y = pk2(bflo(a.y) * e, bfhi(a.y) * e); w.z = pk2(bflo(c2.x) * e, bfhi(c2.x) * e); w.w = pk2(bflo(c2.y) * e, bfhi(c2.y) * e);
                *(u32x4*)(FRu + DFR_QD + (size_t)it * 16) = w;
            }
#pragma unroll
            for (int k = 0; k < 4; ++k) {
                const int it = t4 + 256 * k, f = it >> 6, ln = it & 63, rt = f >> 1, ks = f & 1, dk = 16 * rt + (ln & 15), qd = ln >> 4;
                const bf16* src = QK + (m0 + 32 * ks + 4 * qd) * 1024 + 512 + h * 128 + dk;
                float v[8];
#pragma unroll
                for (int jj = 0; jj < 8; ++jj) { const int ioff = 16 * (jj >> 2) + (jj & 3); v[jj] = bf2f(src[(size_t)ioff * 1024]) * __expf(gl - gcl[32 * ks + 4 * qd + ioff]); }
                u32x4 w; w.x = pk2(v[0], v[1]); w.y = pk2(v[2], v[3]); w.z = pk2(v[4], v[5]); w.w = pk2(v[6], v[7]);
                *(u32x4*)(FRu + DFR_KST + (size_t)it * 16) = w;
            }
        }
        __syncthreads();
        {
#pragma unroll
            for (int k = 0; k < 4; ++k) {
                const int it = t4 + 256 * k, f = it >> 6, ln = it & 63, rt = f >> 2, ks = f & 3, i = 16 * rt + (ln & 15), qd = ln >> 4;
                const LAS unsigned char* s = NWl + i * 272 + (32 * ks + 4 * qd) * 2;
                const u32x2 a = *(const LAS u32x2*)s, c2 = *(const LAS u32x2*)(s + 32);
                u32x4 w; w.x = a.x; w.y = a.y; w.z = c2.x; w.w = c2.y;
                *(u32x4*)(FRu + DFR_NW + (size_t)it * 16) = w;
            }
#pragma unroll
            for (int k = 0; k < 2; ++k) {
                const int it = t4 + 256 * k, f = it >> 6, ln = it & 63, rt = f >> 1, ks = f & 1, i = 16 * rt + (ln & 15), qd = ln >> 4;
                const LAS unsigned char* s = ATl + i * 144 + (32 * ks + 4 * qd) * 2;
                const u32x2 a = *(const LAS u32x2*)s, c2 = *(const LAS u32x2*)(s + 32);
                u32x4 w; w.x = a.x; w.y = a.y; w.z = c2.x; w.w = c2.y;
                *(u32x4*)(FRu + DFR_ATT + (size_t)it * 16) = w;
            }
        }
        __syncthreads();
    }
}
typedef float f32x4v __attribute__((ext_vector_type(4)));
#define MFMA16(a, b, c) __builtin_amdgcn_mfma_f32_16x16x32_bf16((a), (b), (c), 0, 0, 0)
__device__ __forceinline__ u32x4 packB16(const f32x4v& t0, const f32x4v& t1) {
    u32x4 w; w.x = cvtpk(t0[0], t0[1]); w.y = cvtpk(t0[2], t0[3]); w.z = cvtpk(t1[0], t1[1]); w.w = cvtpk(t1[2], t1[3]);
    return w;
}
__device__ __forceinline__ void delta_scan_phase(const unsigned char* FR, const unsigned char* U0, const unsigned char* U1, const float* GL, float* OB,
                                                 LAS unsigned char* lds, int bid, int tid, int lane, int wave) {
    if (bid >= 64) return;
    const int bh = bid & 7, b = bh >> 2, h = bh & 3, col = lane & 15, qd = lane >> 4;
    const int lt = tid - 128, sl = bid >> 3;
    const unsigned char* FRb = FR + (size_t)bh * 128 * DFR_UNIT;
    LAS u32x4* xs = (LAS u32x4*)(lds + 2 * DFR_UNIT) + lane;
    LAS u32x4* xv = (LAS u32x4*)(lds + 2 * DFR_UNIT + 4096) + lane;
#define LD_ISSUE(R, step) do { if ((step) < 128) { const u32x4* g_ = (const u32x4*)(FRb + (size_t)(step) * DFR_UNIT) + lt; \
        _Pragma("unroll") for (int k = 0; k < 9; ++k) R[k] = g_[384 * k]; if (lt < 128) R[9] = g_[384 * 9]; } } while (0)
#define LD_WRITE(R, buf) do { LAS u32x4* d_ = (LAS u32x4*)(lds + (buf) * DFR_UNIT) + lt; \
        _Pragma("unroll") for (int k = 0; k < 9; ++k) d_[384 * k] = R[k]; if (lt < 128) d_[384 * 9] = R[9]; } while (0)
#define LSTEP(c, R) do { LD_WRITE(R, ((c) + 1) & 1); LD_ISSUE(R, (c) + 5); LDS_BARRIER(); LDS_BARRIER(); } while (0)
#define DFRAG_A(g, j) ((g) < 4 ? (DFR_NW / 16) + ((j) * 4 + (g)) * 64 : (DFR_KST / 16) + ((4 * (((g) - 4) & 1) + (j)) * 2 + (((g) - 4) >> 1)) * 64)
#define DFRAG_B(g, j) ((g) < 4 ? (DFR_QD / 16) + ((j) * 4 + (g)) * 64 : (DFR_ATT / 16) + ((j) * 2 + ((g) - 4)) * 64)
    if (wave >= 2) {
        u32x4 R0[10], R1[10], R2[10], R3[10];
        LD_ISSUE(R0, 0); LD_WRITE(R0, 0); LD_ISSUE(R1, 1); LD_ISSUE(R2, 2); LD_ISSUE(R3, 3); LD_ISSUE(R0, 4);
        LDS_BARRIER();
        for (int c = 0; c < 128; c += 4) { LSTEP(c, R1); LSTEP(c + 1, R2); LSTEP(c + 2, R3); LSTEP(c + 3, R0); }
    } else if (wave == 0) {
        f32x4v S[8];
#pragma unroll
        for (int r = 0; r < 8; ++r) S[r] = (f32x4v){0.f, 0.f, 0.f, 0.f};
        u32x4 sp[4];
#pragma unroll
        for (int ks = 0; ks < 4; ++ks) { sp[ks] = (u32x4){0u, 0u, 0u, 0u}; xs[ks * 64] = sp[ks]; }
        u32x2 ucur[4]; float glc;
#pragma unroll
        for (int rt = 0; rt < 4; ++rt) ucur[rt] = *((const u32x2*)(((rt >> 1) == 0 ? U0 : U1) + (size_t)(bh * 128) * DU_UNIT) + (sl * 2 + (rt & 1)) * 64 + lane);
        glc = GL[bh * 128];
        LDS_BARRIER();
        for (int c = 0; c < 128; ++c) {
            const int unit = bh * 128 + c;
            const LAS u32x4* fr = (const LAS u32x4*)(lds + (c & 1) * DFR_UNIT) + lane;
            u32x4 fg[4][4];
#pragma unroll
            for (int j = 0; j < 4; ++j) { fg[0][j] = fr[DFRAG_A(0, j)]; fg[1][j] = fr[DFRAG_A(1, j)]; fg[2][j] = fr[DFRAG_A(2, j)]; }
            f32x4v vn[4];
#pragma unroll
            for (int rt = 0; rt < 4; ++rt) { const u32x2 w = ucur[rt]; vn[rt][0] = bflo(w.x); vn[rt][1] = bfhi(w.x); vn[rt][2] = bflo(w.y); vn[rt][3] = bfhi(w.y); }
            float gln = glc;
            if (c + 1 < 128) {
#pragma unroll
                for (int rt = 0; rt < 4; ++rt) ucur[rt] = *((const u32x2*)(((rt >> 1) == 0 ? U0 : U1) + (size_t)(unit + 1) * DU_UNIT) + (sl * 2 + (rt & 1)) * 64 + lane);
                gln = GL[unit + 1];
            }
            u32x4 vp0, vp1;
#pragma unroll
            for (int g = 0; g < 8; ++g) {
                if (g + 3 < 8) {
#pragma unroll
                    for (int j = 0; j < 4; ++j) fg[(g + 3) & 3][j] = fr[DFRAG_A(g + 3, j)];
                }
                asm volatile("" ::: "memory");
                const bf16x8_t f0 = __builtin_bit_cast(bf16x8_t, fg[g & 3][0]), f1 = __builtin_bit_cast(bf16x8_t, fg[g & 3][1]), f2 = __builtin_bit_cast(bf16x8_t, fg[g & 3][2]), f3 = __builtin_bit_cast(bf16x8_t, fg[g & 3][3]);
                if (g < 4) { const bf16x8_t s = __builtin_bit_cast(bf16x8_t, sp[g]);
                    vn[0] = MFMA16(f0, s, vn[0]); vn[1] = MFMA16(f1, s, vn[1]); vn[2] = MFMA16(f2, s, vn[2]); vn[3] = MFMA16(f3, s, vn[3]);
                    if (g == 3) { vp0 = packB16(vn[0], vn[1]); vp1 = packB16(vn[2], vn[3]); xv[0] = vp0; xv[64] = vp1;
                        LDS_BARRIER();
#pragma unroll
                        for (int r = 0; r < 8; ++r) S[r] *= glc; } }
                else { const int q4 = g - 4, r0 = 4 * (q4 & 1); const bf16x8_t v = __builtin_bit_cast(bf16x8_t, (q4 >> 1) == 0 ? vp0 : vp1);
                    S[r0] = MFMA16(f0, v, S[r0]); S[r0 + 1] = MFMA16(f1, v, S[r0 + 1]); S[r0 + 2] = MFMA16(f2, v, S[r0 + 2]); S[r0 + 3] = MFMA16(f3, v, S[r0 + 3]); }
            }
#pragma unroll
            for (int ks = 0; ks < 4; ++ks) { sp[ks] = packB16(S[2 * ks], S[2 * ks + 1]); xs[ks * 64] = sp[ks]; }
            glc = gln;
            LDS_BARRIER();
        }
    } else {
        LDS_BARRIER();
        for (int c = 0; c < 128; ++c) {
            const LAS u32x4* fr = (const LAS u32x4*)(lds + (c & 1) * DFR_UNIT) + lane;
            u32x4 fg[4][4];
#pragma unroll
            for (int j = 0; j < 4; ++j) { fg[0][j] = fr[DFRAG_B(0, j)]; fg[1][j] = fr[DFRAG_B(1, j)]; fg[2][j] = fr[DFRAG_B(2, j)]; }
            u32x4 spb[4];
#pragma unroll
            for (int ks = 0; ks < 4; ++ks) spb[ks] = xs[ks * 64];
            f32x4v o[4];
#pragma unroll
            for (int rt = 0; rt < 4; ++rt) o[rt] = (f32x4v){0.f, 0.f, 0.f, 0.f};
            u32x4 vp0, vp1;
#pragma unroll
            for (int g = 0; g < 6; ++g) {
                if (g + 3 < 6) {
#pragma unroll
                    for (int j = 0; j < 4; ++j) fg[(g + 3) & 3][j] = fr[DFRAG_B(g + 3, j)];
                }
                asm volatile("" ::: "memory");
                if (g == 4) { LDS_BARRIER(); vp0 = xv[0]; vp1 = xv[64]; }
                const bf16x8_t f0 = __builtin_bit_cast(bf16x8_t, fg[g & 3][0]), f1 = __builtin_bit_cast(bf16x8_t, fg[g & 3][1]), f2 = __builtin_bit_cast(bf16x8_t, fg[g & 3][2]), f3 = __builtin_bit_cast(bf16x8_t, fg[g & 3][3]);
                const bf16x8_t bop = __builtin_bit_cast(bf16x8_t, g < 4 ? spb[g < 4 ? g : 0] : (g == 4 ? vp0 : vp1));
                o[0] = MFMA16(f0, bop, o[0]); o[1] = MFMA16(f1, bop, o[1]); o[2] = MFMA16(f2, bop, o[2]); o[3] = MFMA16(f3, bop, o[3]);
            }
            { float* ob = OB + ((size_t)b * SEQ + c * 64) * 512 + h * 128 + 16 * sl + col;
#pragma unroll
              for (int rt = 0; rt < 4; ++rt)
#pragma unroll
                  for (int j = 0; j < 4; ++j) ob[(size_t)(16 * rt + 4 * qd + j) * 512] = o[rt][j]; }
            LDS_BARRIER();
        }
    }
#undef DFRAG_A
#undef DFRAG_B
#undef LSTEP
#undef LD_ISSUE
#undef LD_WRITE
}

__device__ __forceinline__ void delta_pre_phase(const bf16* PROJ, const float* convw, bf16* QK, bf16* VB, int gw, int NGW, int lane) {
    for (int it = gw; it < (MROWS / 8) * 3; it += NGW) {
        const int blk = it / 3, s = it - blk * 3, t0 = (blk * 8) & (SEQ - 1);
        const size_t m0 = (size_t)blk * 8;
        const bf16* src = PROJ + m0 * NP0 + 1536 + s * 512 + 8 * lane;
        u32x4 xr[11];
#pragma unroll
        for (int r = 0; r < 11; ++r) { if (t0 + r - 3 >= 0) xr[r] = *(const u32x4*)(src + (ptrdiff_t)(r - 3) * NP0); else xr[r] = (u32x4){0u, 0u, 0u, 0u}; }
        float w[4][8];
#pragma unroll
        for (int j = 0; j < 4; ++j) { const f32x4 a = *(const f32x4*)(convw + j * 1536 + s * 512 + 8 * lane), c = *(const f32x4*)(convw + j * 1536 + s * 512 + 8 * lane + 4);
            w[j][0] = a.x; w[j][1] = a.y; w[j][2] = a.z; w[j][3] = a.w; w[j][4] = c.x; w[j][5] = c.y; w[j][6] = c.z; w[j][7] = c.w; }
#pragma unroll
        for (int r = 0; r < 8; ++r) {
            float acc[8], f[8];
#pragma unroll
            for (int i = 0; i < 8; ++i) acc[i] = 0.f;
#pragma unroll
            for (int j = 0; j < 4; ++j) { unpack8(xr[r + j], f);
#pragma unroll
                for (int i = 0; i < 8; ++i) acc[i] += w[j][i] * f[i]; }
            float ss = 0.f;
#pragma unroll
            for (int i = 0; i < 8; ++i) { acc[i] = silu_f(acc[i]); ss += acc[i] * acc[i]; }
            float sc = 1.f;
            if (s < 2) { ss += __shfl_xor(ss, 1); ss += __shfl_xor(ss, 2); ss += __shfl_xor(ss, 4); ss += __shfl_xor(ss, 8); sc = rsqrtf(ss + 1e-6f) * (s == 0 ? 0.08838834764831845f : 1.f); }
            u32x4 o; o.x = pk2(acc[0] * sc, acc[1] * sc); o.y = pk2(acc[2] * sc, acc[3] * sc); o.z = pk2(acc[4] * sc, acc[5] * sc); o.w = pk2(acc[6] * sc, acc[7] * sc);
            if (s < 2) *(u32x4*)(QK + (m0 + r) * 1024 + s * 512 + 8 * lane) = o; else *(u32x4*)(VB + (m0 + r) * 512 + 8 * lane) = o;
        }
    }
}
__device__ __forceinline__ void delta_post_phase(const float* OB, const bf16* PROJ, const float* nw, bf16* MIX, int gw, int NGW, int lane) {
    const int e0 = (8 * lane) & 127;
    const f32x4 w0 = *(const f32x4*)(nw + e0), w1 = *(const f32x4*)(nw + e0 + 4);
    for (int mb = gw; mb < MROWS; mb += 4 * NGW) {
        f32x4 a[4], c[4]; u32x4 z[4];
#pragma unroll
        for (int k = 0; k < 4; ++k) { const size_t m = (size_t)mb + (size_t)k * NGW; if (m < MROWS) { a[k] = *(const f32x4*)(OB + m * 512 + 8 * lane); c[k] = *(const f32x4*)(OB + m * 512 + 8 * lane + 4); z[k] = *(const u32x4*)(PROJ + m * NP0 + 3072 + 8 * lane); } }
#pragma unroll
        for (int k = 0; k < 4; ++k) { const size_t m = (size_t)mb + (size_t)k * NGW; if (m < MROWS) {
            float ss = (a[k].x * a[k].x + a[k].y * a[k].y) + (a[k].z * a[k].z + a[k].w * a[k].w) + (c[k].x * c[k].x + c[k].y * c[k].y) + (c[k].z * c[k].z + c[k].w * c[k].w);
            ss += __shfl_xor(ss, 1); ss += __shfl_xor(ss, 2); ss += __shfl_xor(ss, 4); ss += __shfl_xor(ss, 8);
            const float rs = rsqrtf(ss * (1.f / 128.f) + 1e-6f);
            u32x4 o; o.x = pk2(a[k].x * rs * w0.x * silu_f(bflo(z[k].x)), a[k].y * rs * w0.y * silu_f(bfhi(z[k].x))); o.y = pk2(a[k].z * rs * w0.z * silu_f(bflo(z[k].y)), a[k].w * rs * w0.w * silu_f(bfhi(z[k].y)));
            o.z = pk2(c[k].x * rs * w1.x * silu_f(bflo(z[k].z)), c[k].y * rs * w1.y * silu_f(bfhi(z[k].z))); o.w = pk2(c[k].z * rs * w1.z * silu_f(bflo(z[k].w)), c[k].w * rs * w1.w * silu_f(bfhi(z[k].w)));
            *(u32x4*)(MIX + m * 1024 + 512 + 8 * lane) = o; } }
    }
}
__device__ __forceinline__ void fcum_phase(float* GATES, int gw, int lane) {
    if (gw >= 16) return;
    const int b = gw >> 3, h = gw & 7;
    float* base = GATES + ((size_t)b * SEQ + (size_t)lane * 128) * 16 + 8 + h;
    float tot = 0.f;
#pragma unroll 16
    for (int i = 0; i < 128; ++i) tot += base[(size_t)i * 16];
    float incl = tot;
#pragma unroll
    for (int o = 1; o < 64; o <<= 1) { const float tt = __shfl_up(incl, o); if (lane >= o) incl += tt; }
    float run = incl - tot;
    for (int i0 = 0; i0 < 128; i0 += 16) {
        float v[16];
#pragma unroll
        for (int j = 0; j < 16; ++j) v[j] = base[(size_t)(i0 + j) * 16];
#pragma unroll
        for (int j = 0; j < 16; ++j) { run += v[j]; base[(size_t)(i0 + j) * 16] = run; }
    }
}
__global__ void __launch_bounds__(NTHR, 2) mega_fwd(Params p) {
    extern __shared__ __attribute__((aligned(16))) unsigned char lds_raw[];
    cg::grid_group grid = cg::this_grid();
    LAS unsigned char* lds = (LAS unsigned char*)lds_raw;
    const int wave = __builtin_amdgcn_readfirstlane(threadIdx.x >> 6);
    int lane, tid;
#define REMAT_IDS() do { asm volatile("v_mbcnt_lo_u32_b32 %0, -1, 0\n\tv_mbcnt_hi_u32_b32 %0, -1, %0" : "=v"(lane)); tid = wave * 64 + lane; } while (0)
    REMAT_IDS();
    volatile LAS unsigned* bst = (volatile LAS unsigned*)(lds + 147392);
    if (threadIdx.x < 2) bst[threadIdx.x] = 0u;
    __syncthreads();
    XcdBarrier xbar = xcd_barrier_post((unsigned*)p.ws, bst);
#define GSYNC() do { xcd_barrier(xbar); REMAT_IDS(); } while (0)
    const int G = gridDim.x, bid = blockIdx.x;
    const int gw = bid * NWAVES + wave, NGW = G * NWAVES;
    unsigned char* ws = p.ws;
    bf16* XN = (bf16*)(ws + WS_XN); bf16* MIX = (bf16*)(ws + WS_MIX); bf16* PROJ = (bf16*)(ws + WS_PROJ); float* GATES = (float*)(ws + WS_GATES);
    bf16* VB = (bf16*)(ws + WS_SPARE); bf16* XBC = (bf16*)(ws + WS_XBC);
    float* OUT = p.out;

    weights_phase(p, lds, gw, NGW, wave, lane, 3);
    __syncthreads();
    rows_phase<1>(p.in[0], p.in[1], XN, p.in[7], p.in[10], p.in[11], GATES, lds, gw, NGW, tid, lane);
    grid.sync(); REMAT_IDS();
    { pg8::Gemm g{XN, (const bf16*)(ws + WS_WIN0), MROWS, NP0, DM}; pg8::StaticOrder S; S.init(MROWS, NP0, G, bid);
      pg8::EpiBf16<0> E{PROJ, NP0, nullptr, 0, 0, 1.f};
      pg8::gemm_phase<pg8::EpiBf16<0>, pg8::StaticOrder, true, true>(lds, g, S, E); }
    if (bid >= G / 2) weights_phase(p, lds, (bid - G / 2) * NWAVES + wave, (G - G / 2) * NWAVES, wave, lane, 5);
    GSYNC();
    delta_pre_phase(PROJ, p.in[9], XN  , VB, gw, NGW, lane);
    GSYNC();
    delta_prep_phase(XN  , VB, GATES, (unsigned char*)OUT  , (unsigned char*)OUT + 56 * MiB  , ws + WS_SPARE + 16 * MiB  , (float*)(ws + WS_SPARE + 24 * MiB)  , lds, bid, G, tid, lane, wave);
    GSYNC();
    delta_scan_phase((const unsigned char*)OUT, (const unsigned char*)OUT + 56 * MiB, ws + WS_SPARE + 16 * MiB, (const float*)(ws + WS_SPARE + 24 * MiB), (float*)XN  , lds, bid, tid, lane, wave);
    band_fast_phase(PROJ, p.in[8], MIX, lds, bid, 64, G, tid, lane, wave);
    if (bid >= 64) weights_phase(p, lds, (bid - 64) * NWAVES + wave, (G - 64) * NWAVES, wave, lane, 6);
    GSYNC();
    delta_post_phase((const float*)XN, PROJ, p.in[12], MIX, gw, NGW, lane);
    GSYNC();
    { pg8::Gemm g{MIX, (const bf16*)(ws + WS_WOUT0), MROWS, DM, DM}; pg8::StaticOrder S; S.init(MROWS, DM, G, bid);
      pg8::EpiResRms<0> E{p.in[0], OUT, XN, DM, p.in[2], (float*)(ws + 254 * MiB), (unsigned*)(ws + 65536)};
      pg8::gemm_phase<pg8::EpiResRms<0>, pg8::StaticOrder, false, true>(lds, g, S, E); }
    GSYNC();
    { pg8::Gemm g{XN, (const bf16*)(ws + WS_WGU0), MROWS, 2 * FF, DM}; pg8::StaticOrder S; S.init(MROWS, 2 * FF, G, bid);
      pg8::EpiSwiglu E{PROJ  , FF};
      pg8::gemm_phase<pg8::EpiSwiglu, pg8::StaticOrder, true, true>(lds, g, S, E); }
    GSYNC();
    { pg8::Gemm g{PROJ  , (const bf16*)(ws + WS_WDN0), MROWS, DM, FF}; pg8::StaticOrder S; S.init(MROWS, DM, G, bid);
      pg8::EpiResF32 E{OUT, OUT, DM};
      pg8::gemm_phase<pg8::EpiResF32, pg8::StaticOrder, true, true>(lds, g, S, E); }
    GSYNC();
    rows_phase<2>(OUT, p.in[1] + DM, XN, p.in[14], p.in[17], p.in[21], GATES, lds, gw, NGW, tid, lane);
    GSYNC();
    { pg8::Gemm g{XN, (const bf16*)(ws + WS_WIN1), MROWS, NP1, DM}; pg8::StaticOrder S; S.init(MROWS, NP1, G, bid);
      pg8::EpiBf16<0> E{PROJ, NP1, nullptr, 0, 0, 1.f};
      pg8::gemm_phase<pg8::EpiBf16<0>, pg8::StaticOrder, true, true>(lds, g, S, E); }
    GSYNC();
    ssd_states_phase(PROJ, p.in[15], p.in[16], XBC, GATES, p.in[18], XN  , (float*)(ws + WS_SPARE + 16 * MiB), (unsigned*)(ws + 196608), lds, bid, G, tid, lane, wave);
    GSYNC();
    ssd_scan_phase(XN  , (const float*)(ws + WS_SPARE + 16 * MiB), bid, G, tid);
    if (bid >= G / 2) fcum_phase(GATES, (bid - G / 2) * NWAVES + wave, lane);
    GSYNC();
    ssd_out_phase(XBC, PROJ, GATES, p.in[18], p.in[19], p.in[20], XN  , MIX, lds, bid, G, tid, lane, wave);
    fox_acp_phase(PROJ, GATES, (const unsigned*)(ws + 196608), MIX, lds, bid, G, tid, lane, wave);
    GSYNC();
    { pg8::Gemm g{MIX, (const bf16*)(ws + WS_WOUT1), MROWS, DM, DM}; pg8::StaticOrder S; S.init(MROWS, DM, G, bid);
      pg8::EpiResRms<0> E{OUT, OUT, XN, DM, p.in[2] + DM, (float*)(ws + 254 * MiB), (unsigned*)(ws + 65536 + 16384)};
      pg8::gemm_phase<pg8::EpiResRms<0>, pg8::StaticOrder, false, true>(lds, g, S, E); }
    GSYNC();
    { pg8::Gemm g{XN, (const bf16*)(ws + WS_WGU1), MROWS, 2 * FF, DM}; pg8::StaticOrder S; S.init(MROWS, 2 * FF, G, bid);
      pg8::EpiSwiglu E{PROJ  , FF};
      pg8::gemm_phase<pg8::EpiSwiglu, pg8::StaticOrder, true, true>(lds, g, S, E); }
    GSYNC();
    { pg8::Gemm g{PROJ  , (const bf16*)(ws + WS_WDN1), MROWS, DM, FF}; pg8::StaticOrder S; S.init(MROWS, DM, G, bid);
      pg8::EpiResRms<1> E{OUT, OUT, nullptr, DM, p.in[3], (float*)(ws + 254 * MiB), (unsigned*)(ws + 65536 + 32768)};
      pg8::gemm_phase<pg8::EpiResRms<1>, pg8::StaticOrder, false, true>(lds, g, S, E); }
}

extern "C" void kernel_launch(void* const* d_in, const int* in_sizes, int n_in, void* d_out, int out_size, void* d_ws, size_t ws_size, hipStream_t stream) {
    static int grid = 0;
    if (grid == 0) {
        int dev = 0, cus = 0, per_cu = 0;
        hipGetDevice(&dev);
        hipDeviceGetAttribute(&cus, hipDeviceAttributeMultiprocessorCount, dev);
        if (hipFuncSetAttribute((const void*)mega_fwd, hipFuncAttributeMaxDynamicSharedMemorySize, LDS_BYTES) != hipSuccess) { fprintf(stderr, "hipFuncSetAttribute failed\n"); }
        if (hipOccupancyMaxActiveBlocksPerMultiprocessor(&per_cu, (const void*)mega_fwd, NTHR, LDS_BYTES) != hipSuccess || per_cu < 1) { fprintf(stderr, "occupancy query: %d\n", per_cu); per_cu = 1; }
        (void)hipGetLastError();
        grid = cus * 1;
        if (grid <= 0) grid = 256;
    }
    Params p{};
    for (int i = 0; i < 23; ++i) p.in[i] = (const float*)d_in[i];
    p.out = (float*)d_out; p.ws = (unsigned char*)d_ws;
    (void)hipMemsetAsync(d_ws, 0, 262144, stream);
    void* args[] = {&p};
    hipError_t e = hipLaunchCooperativeKernel((const void*)mega_fwd, dim3(grid), dim3(NTHR), args, LDS_BYTES, stream);
    if (e != hipSuccess) fprintf(stderr, "cooperative launch failed: %s (grid %d)\n", hipGetErrorString(e), grid);
}
```

```cpp
#include <hip/hip_runtime.h>
#include <hip/hip_cooperative_groups.h>
#include <cstdio>
#include <cstdint>
namespace cg = cooperative_groups;
namespace pg8 {
#define PG8_LAS __attribute__((address_space(3)))
typedef unsigned short bf16_t;
typedef short bf16x8 __attribute__((ext_vector_type(8)));
typedef float f32x4 __attribute__((ext_vector_type(4)));
typedef unsigned u32x4 __attribute__((ext_vector_type(4)));
constexpr int BM = 256, BK = 64, HALF = 128, HTB = HALF * BK * 2  , STAGE_BYTES = 8 * HTB, NXCD = 8, WGM = 8;

__host__ __device__ __forceinline__ int lds_byte(int r, int c) { const int st = (r >> 4) * 2 + (c >> 5), rr = r & 15, cc = c & 31, ob = rr * 64 + cc * 2; return st * 1024 + (ob ^ (((ob >> 9) & 1) << 5)); }
__host__ __device__ __forceinline__ void stage_rc(int b, int& R, int& C) { const int st = b / 1024, sb = b % 1024, swz = sb ^ (((sb >> 9) & 1) << 5); R = (st >> 1) * 16 + swz / 64; C = (st & 1) * 32 + (swz % 64) / 2; }
__host__ __device__ __forceinline__ int perm32(int rho) { const int n = rho >> 4, i = rho & 15; return 8 * (i >> 2) + 4 * n + (i & 3); }

struct Unit { int pm, pn; };
struct Gemm { const bf16_t* A; const bf16_t* Bt; int M, N, K; };

struct StaticOrder {
    int nM, nN, nwg, G, c;
    __host__ __device__ void init(int M, int N, int G_, int c_) { nM = M / BM; nN = N / BM; nwg = nM * nN; G = G_; c = c_; }
    __host__ __device__ bool next(int i, Unit& u) const {
        const long L = (long)i * G + c; if (L >= nwg) return false;
        int wgid = (int)L; { const int q = nwg / NXCD, r = nwg % NXCD, xcd = wgid % NXCD, off = wgid / NXCD; wgid = (xcd < r ? xcd * (q + 1) : r * (q + 1) + (xcd - r) * q) + off; }
        const int nig = WGM * nN, gid = wgid / nig, fm = gid * WGM, gsz = (nM - fm) < WGM ? (nM - fm) : WGM;
        u.pm = fm + ((wgid % nig) % gsz); u.pn = (wgid % nig) / gsz; return true;
    }
    __device__ __forceinline__ void a_ready(const Unit&) const {}
    __device__ __forceinline__ void done(const Unit&) const {}
};

__device__ __forceinline__ unsigned cvt_pk_bf16(float lo, float hi) { unsigned r; asm volatile("v_cvt_pk_bf16_f32 %0, %1, %2" : "=v"(r) : "v"(lo), "v"(hi)); return r; }
typedef float f32x2 __attribute__((ext_vector_type(2)));
__device__ __forceinline__ f32x2 gelu_pk(f32x2 v) {
    const f32x2 av = __builtin_elementwise_abs(v), d = av * 0.2316418882f + 1.0f;
    f32x2 t; t.x = __builtin_amdgcn_rcpf(d.x); t.y = __builtin_amdgcn_rcpf(d.y);
    f32x2 q = t * 0.5307027145f + (-0.7265760135f); q = q * t + 0.7107068705f; q = q * t + (-0.142248368f); q = q * t + 0.127414796f; q = q * t;
    const f32x2 s = (v * v) * (-0.72134752044f);
    f32x2 e; e.x = __builtin_amdgcn_exp2f(s.x); e.y = __builtin_amdgcn_exp2f(s.y);
    const f32x2 m = v * (q * e), r = v - m;
    f32x2 o; o.x = v.x < 0.f ? m.x : r.x; o.y = v.y < 0.f ? m.y : r.y; return o;
}

template <int ACT  > struct EpiBf16 {
    static constexpr bool PERM = true, AFTER_DRAIN = false; static_assert(ACT == 0 || ACT == 1, "EpiBf16: ACT is 0 (none) or 1 (gelu_pk)");
    bf16_t* O; int ldc; const float* bias; int split_cols; size_t split_stride; float scale0;
    __device__ __forceinline__ void operator()(const f32x4 (&acc)[2][2][4][2], const Unit& u, int wr, int wc, int fr, int fq) const {
        const int row0 = u.pm * BM + wr * 64 + fr; int colt = u.pn * BM; bf16_t* base = O;
        float sc = 1.f; if (split_cols) { const int t = colt / split_cols; base += (size_t)t * split_stride; colt -= t * split_cols; if (t == 0) sc = scale0; }
        const int col0 = colt + wc * 32 + 8 * fq, bcol0 = u.pn * BM + wc * 32 + 8 * fq;
        f32x4 bv[2][2];
#pragma unroll
        for (int bj = 0; bj < 2; ++bj)
#pragma unroll
            for (int n = 0; n < 2; ++n) bv[bj][n] = bias ? *(const f32x4*)(bias + bcol0 + bj * HALF + 4 * n) : (f32x4){0.f, 0.f, 0.f, 0.f};
#pragma unroll
        for (int ai = 0; ai < 2; ++ai)
#pragma unroll
            for (int m = 0; m < 4; ++m) { bf16_t* rowp = base + (size_t)(row0 + ai * HALF + m * 16) * ldc + col0;
#pragma unroll
                for (int bj = 0; bj < 2; ++bj) { f32x4 v0 = acc[ai][bj][m][0] + bv[bj][0], v1 = acc[ai][bj][m][1] + bv[bj][1];
                    if (ACT == 1) { f32x2 a = gelu_pk((f32x2){v0[0], v0[1]}), b = gelu_pk((f32x2){v0[2], v0[3]}), c = gelu_pk((f32x2){v1[0], v1[1]}), d = gelu_pk((f32x2){v1[2], v1[3]});
                        v0 = (f32x4){a.x, a.y, b.x, b.y}; v1 = (f32x4){c.x, c.y, d.x, d.y}; }
                    v0 = v0 * sc; v1 = v1 * sc; u32x4 w; w.x = cvt_pk_bf16(v0[0], v0[1]); w.y = cvt_pk_bf16(v0[2], v0[3]); w.z = cvt_pk_bf16(v1[0], v1[1]); w.w = cvt_pk_bf16(v1[2], v1[3]);
                    *(u32x4*)(rowp + bj * HALF) = w; } }
    }
};
template <class Epi, class Sched, bool ALIGN_EPI = false, bool SP2 = false>
__device__ __forceinline__ void gemm_phase(PG8_LAS unsigned char* lds, const Gemm g, const Sched& S, const Epi& E) {
    const int tid = threadIdx.x, wid = __builtin_amdgcn_readfirstlane(tid >> 6), lane = tid & 63, wr = wid >> 2, wc = wid & 3, fr = lane & 15, fq = lane >> 4;
    const int K = g.K, nt = K / BK;
    unsigned voffA[2], voffB[2];
#pragma unroll
    for (int i = 0; i < 2; ++i) { int R, C; stage_rc(tid * 16 + i * 8192, R, C); const int Rb = Epi::PERM ? ((R & ~31) + perm32(R & 31)) : R;
        voffA[i] = (unsigned)(R * K + C) * 2u; voffB[i] = (unsigned)(Rb * K + C) * 2u; }
    const size_t kstep = (size_t)(BK * 2);
    const size_t hstep = (size_t)HALF * K * 2;
    const size_t tstep = 2 * hstep;
    const unsigned ldsw = (unsigned)wid * 1024u;
    const int aoff = lds_byte(wr * 64 + fr, fq * 8), boff = lds_byte(wc * 32 + fr, fq * 8);
#define PG8_SA(b, h) (((b) * 2 + (h)) * HTB)
#define PG8_SB(b, h) ((4 + (b) * 2 + (h)) * HTB)
#define PG8_STAGE(bufoff, gbase, voff) do { _Pragma("unroll") for (int _i = 0; _i < 2; ++_i) \
        __builtin_amdgcn_global_load_lds((const unsigned*)((const char*)(gbase) + (voff)[_i]), (PG8_LAS unsigned*)(lds + (bufoff) + ldsw + _i * 8192), 16, 0, 0); } while (0)
#define PG8_LDA(dst, b, h) do { _Pragma("unroll") for (int m = 0; m < 4; ++m) _Pragma("unroll") for (int k = 0; k < 2; ++k) dst[m][k] = *(const PG8_LAS bf16x8*)(lds + PG8_SA(b, h) + aoff + m * 2048 + k * 1024); } while (0)
#define PG8_LDB(dst, b, h) do { _Pragma("unroll") for (int n = 0; n < 2; ++n) _Pragma("unroll") for (int k = 0; k < 2; ++k) dst[n][k] = *(const PG8_LAS bf16x8*)(lds + PG8_SB(b, h) + boff + n * 2048 + k * 1024); } while (0)
#define PG8_MMA(ai, bj, At, Bt) do { __builtin_amdgcn_s_setprio(1); _Pragma("unroll") for (int m = 0; m < 4; ++m) _Pragma("unroll") for (int n = 0; n < 2; ++n) _Pragma("unroll") for (int k = 0; k < 2; ++k) \
        acc[ai][bj][m][n] = __builtin_amdgcn_mfma_f32_16x16x32_bf16(Bt[n][k], At[m][k], acc[ai][bj][m][n], 0, 0, 0); __builtin_amdgcn_s_setprio(0); } while (0)
#define PG8_WAIT_V(n) asm volatile("s_waitcnt vmcnt(" #n ")" ::: "memory")
#define PG8_WAIT_L(n) asm volatile("s_waitcnt lgkmcnt(" #n ")" ::: "memory")
#define PG8_BAR __builtin_amdgcn_s_barrier()
#define PG8_SCHED __builtin_amdgcn_sched_barrier(0)
    Unit cur, nxt; int ui = 0;
    if (!S.next(0, cur)) return;
    f32x4 acc[2][2][4][2];
#pragma unroll
    for (int a = 0; a < 2; ++a)
#pragma unroll
        for (int b = 0; b < 2; ++b)
#pragma unroll
            for (int m = 0; m < 4; ++m)
#pragma unroll
                for (int n = 0; n < 2; ++n) acc[a][b][m][n] = (f32x4){0.f, 0.f, 0.f, 0.f};
    bf16x8 At[4][2], B0[2][2], B1[2][2];
    const char* cA = (const char*)g.A + (size_t)cur.pm * tstep; const char* cB = (const char*)g.Bt + (size_t)cur.pn * tstep;
    S.a_ready(cur);
    if constexpr (SP2) {
        PG8_STAGE(PG8_SB(0, 0), cB, voffB); PG8_STAGE(PG8_SB(0, 1), cB + hstep, voffB); PG8_STAGE(PG8_SA(0, 0), cA, voffA); PG8_STAGE(PG8_SA(0, 1), cA + hstep, voffA);
        if (wr == 1) PG8_BAR;
        PG8_WAIT_V(2); PG8_BAR;
        PG8_STAGE(PG8_SB(1, 0), cB + kstep, voffB); PG8_STAGE(PG8_SA(1, 0), cA + kstep, voffA); PG8_STAGE(PG8_SB(1, 1), cB + hstep + kstep, voffB);
        PG8_WAIT_V(6); PG8_BAR;
    } else {
        PG8_STAGE(PG8_SB(0, 0), cB, voffB); PG8_STAGE(PG8_SA(0, 0), cA, voffA); PG8_STAGE(PG8_SB(0, 1), cB + hstep, voffB); PG8_STAGE(PG8_SA(0, 1), cA + hstep, voffA);
        if (wr == 1) PG8_BAR;
        PG8_WAIT_V(4); PG8_BAR;
        PG8_STAGE(PG8_SB(1, 0), cB + kstep, voffB); PG8_STAGE(PG8_SA(1, 0), cA + kstep, voffA); PG8_STAGE(PG8_SB(1, 1), cB + hstep + kstep, voffB);
        PG8_WAIT_V(6); PG8_BAR;
    }
    for (;;) {
        const bool has_next = S.next(ui + 1, nxt);
        const char* nA = has_next ? (const char*)g.A + (size_t)nxt.pm * tstep : cA; const char* nB = has_next ? (const char*)g.Bt + (size_t)nxt.pn * tstep : cB;
        for (int t = 0; t < nt; t += 2) {
            const bool last = (t == nt - 2);
            const char* a1 = cA + (size_t)(t + 1) * kstep;
            const char* a2 = last ? nA : cA + (size_t)(t + 2) * kstep; const char* b2 = last ? nB : cB + (size_t)(t + 2) * kstep;
            const char* a3 = a2 + kstep; const char* b3 = b2 + kstep;
            if (last && has_next) S.a_ready(nxt);
            if constexpr (SP2) {
            PG8_LDB(B0, 0, 0); PG8_LDB(B1, 0, 1); PG8_SCHED; PG8_LDA(At, 0, 0); PG8_STAGE(PG8_SA(1, 1), a1 + hstep, voffA);
            PG8_WAIT_V(8); PG8_WAIT_L(0); PG8_BAR; PG8_MMA(0, 0, At, B0); PG8_MMA(0, 1, At, B1); PG8_BAR; PG8_SCHED;
            PG8_LDA(At, 0, 1); PG8_STAGE(PG8_SB(0, 0), b2, voffB); PG8_STAGE(PG8_SB(0, 1), b2 + hstep, voffB); PG8_STAGE(PG8_SA(0, 0), a2, voffA);
            PG8_WAIT_V(8); PG8_WAIT_L(0); PG8_BAR; PG8_MMA(1, 0, At, B0); PG8_MMA(1, 1, At, B1); PG8_BAR; PG8_SCHED;
            PG8_LDB(B0, 1, 0); PG8_LDB(B1, 1, 1); PG8_SCHED; PG8_LDA(At, 1, 0); PG8_STAGE(PG8_SA(0, 1), a2 + hstep, voffA);
            PG8_WAIT_V(8); PG8_WAIT_L(0); PG8_BAR; PG8_MMA(0, 0, At, B0); PG8_MMA(0, 1, At, B1); PG8_BAR; PG8_SCHED;
            PG8_LDA(At, 1, 1); PG8_STAGE(PG8_SB(1, 0), b3, voffB); PG8_STAGE(PG8_SB(1, 1), b3 + hstep, voffB); PG8_STAGE(PG8_SA(1, 0), a3, voffA);
            PG8_WAIT_V(8); PG8_WAIT_L(0); PG8_BAR; PG8_MMA(1, 0, At, B0); PG8_MMA(1, 1, At, B1); PG8_BAR; PG8_SCHED;
            } else {
            PG8_LDB(B0, 0, 0); PG8_SCHED; PG8_LDA(At, 0, 0); PG8_STAGE(PG8_SA(1, 1), a1 + hstep, voffA);
            PG8_WAIT_L(8); PG8_BAR; PG8_WAIT_L(0); PG8_MMA(0, 0, At, B0); PG8_BAR; PG8_SCHED;
            PG8_LDB(B1, 0, 1); PG8_STAGE(PG8_SB(0, 0), b2, voffB);
            PG8_BAR; PG8_WAIT_L(0); PG8_MMA(0, 1, At, B1); PG8_BAR;
            PG8_LDA(At, 0, 1); PG8_STAGE(PG8_SA(0, 0), a2, voffA);
            PG8_BAR; PG8_WAIT_L(0); PG8_MMA(1, 0, At, B0); PG8_BAR; PG8_SCHED;
            PG8_STAGE(PG8_SB(0, 1), b2 + hstep, voffB);
            PG8_WAIT_V(6); PG8_BAR; PG8_MMA(1, 1, At, B1); PG8_BAR;
            PG8_LDB(B0, 1, 0); PG8_SCHED; PG8_LDA(At, 1, 0); PG8_STAGE(PG8_SA(0, 1), a2 + hstep, voffA);
            PG8_WAIT_L(8); PG8_BAR; PG8_WAIT_L(0); PG8_MMA(0, 0, At, B0); PG8_BAR; PG8_SCHED;
            PG8_LDB(B1, 1, 1); PG8_STAGE(PG8_SB(1, 0), b3, voffB);
            PG8_BAR; PG8_WAIT_L(0); PG8_MMA(0, 1, At, B1); PG8_BAR;
            PG8_LDA(At, 1, 1); PG8_STAGE(PG8_SA(1, 0), a3, voffA);
            PG8_BAR; PG8_WAIT_L(0); PG8_MMA(1, 0, At, B0); PG8_BAR; PG8_SCHED;
            PG8_STAGE(PG8_SB(1, 1), b3 + hstep, voffB);
            PG8_WAIT_V(6); PG8_BAR; PG8_MMA(1, 1, At, B1); PG8_BAR;
            }
        }
        if constexpr (ALIGN_EPI) { if (wr == 0) PG8_BAR; }
        if constexpr (!Epi::AFTER_DRAIN) { E(acc, cur, wr, wc, fr, fq); S.done(cur); }
        if (!has_next) break;
#pragma unroll
        for (int a = 0; a < 2; ++a)
#pragma unroll
            for (int b = 0; b < 2; ++b)
#pragma unroll
                for (int m = 0; m < 4; ++m)
#pragma unroll
                    for (int n = 0; n < 2; ++n) acc[a][b][m][n] = (f32x4){0.f, 0.f, 0.f, 0.f};
        cur = nxt; cA = nA; cB = nB; ++ui;
        if constexpr (ALIGN_EPI) { if (wr == 1) PG8_BAR; }
    }
    PG8_WAIT_V(0);
    if constexpr (!ALIGN_EPI) { if (wr == 0) PG8_BAR; }
    PG8_BAR;
    if constexpr (Epi::AFTER_DRAIN) { E.fused(acc, cur, wr, wc, fr, fq, lds, wid, lane); S.done(cur); }
#undef PG8_SA
#undef PG8_SB
#undef PG8_STAGE
#undef PG8_LDA
#undef PG8_LDB
#undef PG8_MMA
#undef PG8_WAIT_V
#undef PG8_WAIT_L
#undef PG8_BAR
#undef PG8_SCHED
}
}

constexpr int BATCH = 2, SEQ = 8192, DM = 1024, FF = 2816, MROWS = BATCH * SEQ;
constexpr int NP0 = 3584, NP1 = 3072, LDW0 = 3592, LDW1 = 3088;
constexpr int NTHR = 512, NWAVES = 8;
constexpr int LDS_BYTES = 147456;
constexpr size_t MiB = 1u << 20;
constexpr size_t WS_WIN0 = 1 * MiB, WS_WOUT0 = 8 * MiB, WS_WGU0 = 10 * MiB, WS_WDN0 = 21 * MiB;
constexpr size_t WS_WIN1 = 27 * MiB, WS_WOUT1 = 33 * MiB, WS_WGU1 = 35 * MiB, WS_WDN1 = 46 * MiB;
constexpr size_t WS_GATES = 52 * MiB, WS_XN = 53 * MiB, WS_MIX = 85 * MiB, WS_PROJ = 117 * MiB, WS_SPARE = 229 * MiB;
constexpr size_t WS_XBC = 213 * MiB;

#define LAS __attribute__((address_space(3)))
typedef unsigned short bf16;
typedef float f32x4 __attribute__((ext_vector_type(4)));
typedef unsigned u32x4 __attribute__((ext_vector_type(4)));
typedef unsigned u32x2 __attribute__((ext_vector_type(2)));
#define LDS_WAIT() asm volatile("s_waitcnt lgkmcnt(0)" ::: "memory")
#define LDS_BARRIER() do { asm volatile("s_waitcnt lgkmcnt(0)" ::: "memory"); __builtin_amdgcn_s_barrier(); asm volatile("" ::: "memory"); } while (0)

__device__ __forceinline__ float bf2f(unsigned v) { return __uint_as_float(v << 16); }
__device__ __forceinline__ float bflo(unsigned w) { return __uint_as_float(w << 16); }
__device__ __forceinline__ float bfhi(unsigned w) { return __uint_as_float(w & 0xffff0000u); }
__device__ __forceinline__ unsigned f2bf(float f) { unsigned u = __float_as_uint(f); return (u + 0x7fffu + ((u >> 16) & 1u)) >> 16; }
__device__ __forceinline__ unsigned pk2(float lo, float hi) { return f2bf(lo) | (f2bf(hi) << 16); }
__device__ __forceinline__ float silu_f(float x) { return x / (1.f + __expf(-x)); }
__device__ __forceinline__ float sigmoid_f(float x) { return 1.f / (1.f + __expf(-x)); }
__device__ __forceinline__ float softplus_f(float x) { return fmaxf(x, 0.f) + log1pf(__expf(-fabsf(x))); }
__device__ __forceinline__ float wave_sum(float v) {
#pragma unroll
    for (int o = 1; o < 64; o <<= 1) v += __shfl_xor(v, o);
    return v;
}

__device__ __forceinline__ void unpack8(const u32x4 w, float* f) { f[0] = bflo(w.x); f[1] = bfhi(w.x); f[2] = bflo(w.y); f[3] = bfhi(w.y); f[4] = bflo(w.z); f[5] = bfhi(w.z); f[6] = bflo(w.w); f[7] = bfhi(w.w); }

struct Params { const float* in[23]; float* out; unsigned char* ws; };

struct TJob { const float* s0; const float* s1; bf16* dst; int K, N, ld, thr, mode; };
__device__ __forceinline__ void transpose_item(const TJob J, LAS float* scr, int item, int lane) {
    const int nblk = J.N / 32, kb = item / nblk, nb = item % nblk, k0 = 64 * kb, n0 = 32 * nb;
    const int nd = n0 + (lane & 31);
    const float* src;
    if (J.mode == 0) src = J.s0 + (nd + (nd >= J.thr ? 8 : 0));
    else { const int c = (nd >> 3) * 4 + (nd & 3); src = ((nd & 4) ? J.s1 : J.s0) + c; }
    float tv[32];
#pragma unroll
    for (int i = 0; i < 32; ++i) tv[i] = __builtin_nontemporal_load(src + (size_t)(k0 + 2 * i + (lane >> 5)) * J.ld);
#pragma unroll
    for (int i = 0; i < 32; ++i) scr[(2 * i + (lane >> 5)) * 33 + (lane & 31)] = tv[i];
    LDS_WAIT();
    const int c = lane & 7;
#pragma unroll
    for (int j = 0; j < 4; ++j) { const int n = (lane >> 3) + 8 * j; const LAS float* s = scr + (8 * c) * 33 + n;
        u32x4 o; o.x = pk2(s[0 * 33], s[1 * 33]); o.y = pk2(s[2 * 33], s[3 * 33]); o.z = pk2(s[4 * 33], s[5 * 33]); o.w = pk2(s[6 * 33], s[7 * 33]);
        *(u32x4*)(J.dst + (size_t)(n0 + n) * J.K + k0 + 8 * c) = o; }
    LDS_WAIT();
}
__device__ __forceinline__ void weights_phase(const Params& p, LAS unsigned char* lds, int gw, int NGW, int wave, int lane, int layer) {
    LAS float* scr = (LAS float*)(lds + wave * 16384);
    unsigned char* ws = p.ws;
    constexpr int I_IN0 = 16 * (NP0 / 32), I_OUT = 16 * 32, I_GU = 16 * (2 * FF / 32), I_DN = (FF / 64) * 32, I_IN1 = 16 * (NP1 / 32);
    constexpr int PER_L0 = I_IN0 + I_OUT + I_GU + I_DN, PER_L1 = I_IN1 + I_OUT + I_GU + I_DN;
    const int it_lo = layer == 0 ? 0 : layer == 1 ? PER_L0 : layer == 2 ? PER_L0 + PER_L1 / 2 : layer == 3 ? 0 : layer == 4 ? I_IN0 : layer == 5 ? I_IN0 : PER_L0;
    const int it_hi = layer == 0 ? PER_L0 : layer == 1 ? PER_L0 + PER_L1 / 2 : layer == 2 ? PER_L0 + PER_L1 : layer == 3 ? I_IN0 : layer == 4 ? PER_L0 + PER_L1 : layer == 5 ? PER_L0 : PER_L0 + PER_L1;
    for (int it = it_lo + gw; it < it_hi; it += NGW) {
        int r = it; TJob J;
        if (r < PER_L0) {
            if (r < I_IN0) J = TJob{p.in[7], nullptr, (bf16*)(ws + WS_WIN0), DM, NP0, LDW0, 3072, 0};
            else if ((r -= I_IN0) < I_OUT) J = TJob{p.in[13], nullptr, (bf16*)(ws + WS_WOUT0), DM, DM, DM, 1 << 30, 0};
            else if ((r -= I_OUT) < I_GU) J = TJob{p.in[4], p.in[5], (bf16*)(ws + WS_WGU0), DM, 2 * FF, FF, 0, 1};
            else { r -= I_GU; J = TJob{p.in[6], nullptr, (bf16*)(ws + WS_WDN0), FF, DM, DM, 1 << 30, 0}; }
        } else {
            r -= PER_L0;
            if (r < I_IN1) J = TJob{p.in[14], nullptr, (bf16*)(ws + WS_WIN1), DM, NP1, LDW1, 1536, 0};
            else if ((r -= I_IN1) < I_OUT) J = TJob{p.in[22], nullptr, (bf16*)(ws + WS_WOUT1), DM, DM, DM, 1 << 30, 0};
            else if ((r -= I_OUT) < I_GU) J = TJob{p.in[4] + (size_t)DM * FF, p.in[5] + (size_t)DM * FF, (bf16*)(ws + WS_WGU1), DM, 2 * FF, FF, 0, 1};
            else { r -= I_GU; J = TJob{p.in[6] + (size_t)FF * DM, nullptr, (bf16*)(ws + WS_WDN1), FF, DM, DM, 1 << 30, 0}; }
        }
        transpose_item(J, scr, r, lane);
    }
}

template <int GM>
__device__ __forceinline__ void rows_phase(const float* X, const float* nw, bf16* XN, const float* Win, const float* pA, const float* pB,
                                           float* GATES, LAS unsigned char* lds, int gw, int NGW, int tid, int lane) {
    constexpr int NG = GM == 1 ? 8 : 16;
    LAS float* Wl = (LAS float*)lds;
    if (GM != 0) {
        float tmpw[2 * NG];
#pragma unroll
        for (int i = 0; i < 2 * NG; ++i) { const int idx = tid + NTHR * i, k = idx / NG, g = idx % NG;
            int col; int ld;
            if (GM == 1) { col = 3072 + g; ld = LDW0; } else { col = g < 8 ? 1536 + g : 3080 + (g - 8); ld = LDW1; }
            tmpw[i] = Win[(size_t)k * ld + col]; }
#pragma unroll
        for (int i = 0; i < 2 * NG; ++i) { const int idx = tid + NTHR * i, k = idx / NG, g = idx % NG; Wl[g * 1024 + k] = tmpw[i]; }
        __syncthreads();
    }
    f32x4 wv[4];
#pragma unroll
    for (int j = 0; j < 4; ++j) wv[j] = *(const f32x4*)(nw + 256 * j + 4 * lane);
    for (int mb = gw; mb < MROWS; mb += 4 * NGW) {
        f32x4 vv[4][4];
#pragma unroll
        for (int k = 0; k < 4; ++k) { const size_t m = (size_t)mb + (size_t)k * NGW; if (m < MROWS) { const f32x4* xr = (const f32x4*)(X + m * DM) + lane;
#pragma unroll
            for (int j = 0; j < 4; ++j) vv[k][j] = xr[64 * j]; } }
#pragma unroll
        for (int k = 0; k < 4; ++k) { const size_t m = (size_t)mb + (size_t)k * NGW; if (m < MROWS) {
        f32x4 v[4]; float s = 0.f;
#pragma unroll
        for (int j = 0; j < 4; ++j) { v[j] = vv[k][j]; s += (v[j].x * v[j].x + v[j].y * v[j].y) + (v[j].z * v[j].z + v[j].w * v[j].w); }
        const float rstd = 1.f / sqrtf(wave_sum(s) * (1.f / DM) + 1e-6f);
#pragma unroll
        for (int j = 0; j < 4; ++j) v[j] = v[j] * rstd * wv[j];
        u32x2* o8 = (u32x2*)(XN + m * DM) + lane;
#pragma unroll
        for (int j = 0; j < 4; ++j) { u32x2 w; w.x = pk2(v[j].x, v[j].y); w.y = pk2(v[j].z, v[j].w); o8[64 * j] = w; }
        if (GM != 0) {
            float ga[NG];
#pragma unroll
            for (int g = 0; g < NG; ++g) {
                float a = 0.f;
#pragma unroll
                for (int j = 0; j < 4; ++j) { const f32x4 w4 = *(const LAS f32x4*)(Wl + g * 1024 + 256 * j + 4 * lane); a += (v[j].x * w4.x + v[j].y * w4.y) + (v[j].z * w4.z + v[j].w * w4.w); }
                ga[g] = a;
            }
            int gidx = 0;
#define GATE_STEP(N, OFF) do { const bool up = (lane & (OFF)) != 0; \
                _Pragma("unroll") for (int i = 0; i < (N); ++i) { const float keep = up ? ga[i + (N)] : ga[i], send = up ? ga[i] : ga[i + (N)]; ga[i] = keep + __shfl_xor(send, (OFF)); } \
                gidx = gidx * 2 + (up ? 1 : 0); } while (0)
            if constexpr (NG == 16) { GATE_STEP(8, 32); GATE_STEP(4, 16); GATE_STEP(2, 8); GATE_STEP(1, 4); }
            else { GATE_STEP(4, 32); GATE_STEP(2, 16); GATE_STEP(1, 8); }
#undef GATE_STEP
            float val = ga[0];
            if (NG == 16) { val += __shfl_xor(val, 2); val += __shfl_xor(val, 1); } else { val += __shfl_xor(val, 4); val += __shfl_xor(val, 2); val += __shfl_xor(val, 1); }
            if ((lane & (NG == 16 ? 3 : 7)) == 0) {
                float r;
                if (GM == 1) { if (gidx < 4) r = sigmoid_f(val); else { const int h = gidx - 4; r = -__expf(pA[h]) * softplus_f(val + pB[h]); } }
                else { if (gidx < 8) r = softplus_f(val + pA[gidx]); else r = -softplus_f(-(val + pB[gidx - 8])); }
                GATES[m * 16 + gidx] = r;
            }
        }
        } }
    }
}

namespace pg8 {
struct EpiResF32 {
    static constexpr bool PERM = false, AFTER_DRAIN = false;
    const float* base; float* out; int ldc;
    __device__ __forceinline__ void operator()(const f32x4 (&acc)[2][2][4][2], const Unit& u, int wr, int wc, int fr, int fq) const {
        const int col0 = u.pn * BM + wc * 32 + 4 * fq;
#pragma unroll
        for (int ai = 0; ai < 2; ++ai)
#pragma unroll
            for (int m = 0; m < 4; ++m) { const size_t off = (size_t)(u.pm * BM + ai * HALF + wr * 64 + m * 16 + fr) * ldc + col0;
#pragma unroll
                for (int bj = 0; bj < 2; ++bj)
#pragma unroll
                    for (int n = 0; n < 2; ++n) { const f32x4 bs = *(const f32x4*)(base + off + bj * HALF + n * 16); *(f32x4*)(out + off + bj * HALF + n * 16) = bs + acc[ai][bj][m][n]; } }
    }
};
struct EpiSwiglu {
    static constexpr bool PERM = true, AFTER_DRAIN = false;
    bf16_t* H; int ldh;
    __device__ __forceinline__ void operator()(const f32x4 (&acc)[2][2][4][2], const Unit& u, int wr, int wc, int fr, int fq) const {
        const int row0 = u.pm * BM + wr * 64 + fr; const int hcol0 = (u.pn * BM + wc * 32 + 8 * fq) >> 1;
#pragma unroll
        for (int ai = 0; ai < 2; ++ai)
#pragma unroll
            for (int m = 0; m < 4; ++m) { bf16_t* rowp = H + (size_t)(row0 + ai * HALF + m * 16) * ldh + hcol0;
#pragma unroll
                for (int bj = 0; bj < 2; ++bj) { const f32x4 g = acc[ai][bj][m][0], v = acc[ai][bj][m][1];
                    float h0 = g[0] / (1.f + __expf(-g[0])) * v[0], h1 = g[1] / (1.f + __expf(-g[1])) * v[1], h2 = g[2] / (1.f + __expf(-g[2])) * v[2], h3 = g[3] / (1.f + __expf(-g[3])) * v[3];
                    typedef unsigned u32x2v __attribute__((ext_vector_type(2))); u32x2v w; w.x = cvt_pk_bf16(h0, h1); w.y = cvt_pk_bf16(h2, h3);
                    *(u32x2v*)(rowp + bj * (HALF / 2)) = w; } }
    }
};
template <int MODE>
struct EpiResRms {
    static constexpr bool PERM = false, AFTER_DRAIN = true;
    const float* base; float* out; bf16_t* xn; int ldc; const float* nw; float* slots; unsigned* cnt;
    __device__ __forceinline__ void fused(f32x4 (&acc)[2][2][4][2], const Unit& u, int wr, int wc, int fr, int fq, PG8_LAS unsigned char* lds, int wid, int lane) const {
        PG8_LAS float* P = (PG8_LAS float*)lds;
        PG8_LAS float* S = (PG8_LAS float*)(lds + 4096);
        const int col0 = u.pn * BM + wc * 32 + 4 * fq;
#pragma unroll
        for (int ai = 0; ai < 2; ++ai)
#pragma unroll
            for (int m = 0; m < 4; ++m) { const int rl = ai * HALF + wr * 64 + m * 16 + fr; const size_t off = (size_t)(u.pm * BM + rl) * ldc + col0; float ss = 0.f;
#pragma unroll
                for (int bj = 0; bj < 2; ++bj)
#pragma unroll
                    for (int n = 0; n < 2; ++n) { const f32x4 v = *(const f32x4*)(base + off + bj * HALF + n * 16) + acc[ai][bj][m][n]; acc[ai][bj][m][n] = v;
                        ss += (v[0] * v[0] + v[1] * v[1]) + (v[2] * v[2] + v[3] * v[3]); }
                ss += __shfl_xor(ss, 16); ss += __shfl_xor(ss, 32);
                if (fq == 0) P[rl * 4 + wc] = ss;
                if (m & 1) asm volatile("" ::: "memory"); }
        asm volatile("s_waitcnt lgkmcnt(0)" ::: "memory"); __builtin_amdgcn_s_barrier(); asm volatile("" ::: "memory");
        const int t = wid * 64 + lane;
        if (t < 256) { const float tot = (P[t * 4] + P[t * 4 + 1]) + (P[t * 4 + 2] + P[t * 4 + 3]);
            __hip_atomic_store(slots + (size_t)(u.pm * BM + t) * 4 + u.pn, tot, __ATOMIC_RELAXED, __HIP_MEMORY_SCOPE_AGENT); }
        asm volatile("s_waitcnt vmcnt(0)" ::: "memory");
        if (lane == 0) __hip_atomic_fetch_add(cnt + 64 * u.pm, 1u, __ATOMIC_RELAXED, __HIP_MEMORY_SCOPE_AGENT);
        if (wid == 0) {
            unsigned spins = 0;
            while ((unsigned)__builtin_amdgcn_readfirstlane(__hip_atomic_load(cnt + 64 * u.pm, __ATOMIC_RELAXED, __HIP_MEMORY_SCOPE_AGENT)) < 32u) { __builtin_amdgcn_s_sleep(2); if (++spins > (1u << 18)) break; }
            __builtin_amdgcn_fence(__ATOMIC_ACQUIRE, "agent");
        }
        asm volatile("s_waitcnt vmcnt(0) lgkmcnt(0)" ::: "memory"); __builtin_amdgcn_s_barrier(); asm volatile("" ::: "memory");
        if (t < 256) { const float* sl = slots + (size_t)(u.pm * BM + t) * 4;
            const float tot = (__hip_atomic_load(sl, __ATOMIC_RELAXED, __HIP_MEMORY_SCOPE_AGENT) + __hip_atomic_load(sl + 1, __ATOMIC_RELAXED, __HIP_MEMORY_SCOPE_AGENT))
                            + (__hip_atomic_load(sl + 2, __ATOMIC_RELAXED, __HIP_MEMORY_SCOPE_AGENT) + __hip_atomic_load(sl + 3, __ATOMIC_RELAXED, __HIP_MEMORY_SCOPE_AGENT));
            S[t] = 1.f / sqrtf(tot * (1.f / 1024.f) + 1e-6f); }
        asm volatile("s_waitcnt vmcnt(0) lgkmcnt(0)" ::: "memory"); __builtin_amdgcn_s_barrier(); asm volatile("" ::: "memory");
        f32x4 wv[2][2];
#pragma unroll
        for (int bj = 0; bj < 2; ++bj)
#pragma unroll
            for (int n = 0; n < 2; ++n) wv[bj][n] = *(const f32x4*)(nw + col0 + bj * HALF + n * 16);
#pragma unroll
        for (int ai = 0; ai < 2; ++ai)
#pragma unroll
            for (int m = 0; m < 4; ++m) { const int rl = ai * HALF + wr * 64 + m * 16 + fr; const size_t off = (size_t)(u.pm * BM + rl) * ldc + col0; const float rs = S[rl];
#pragma unroll
                for (int bj = 0; bj < 2; ++bj)
#pragma unroll
                    for (int n = 0; n < 2; ++n) { const f32x4 v = acc[ai][bj][m][n]; const f32x4 y = v * rs * wv[bj][n];
                        if (MODE == 0) { *(f32x4*)(out + off + bj * HALF + n * 16) = v;
                            typedef unsigned u32x2v __attribute__((ext_vector_type(2))); u32x2v w; w.x = cvt_pk_bf16(y[0], y[1]); w.y = cvt_pk_bf16(y[2], y[3]); *(u32x2v*)(xn + off + bj * HALF + n * 16) = w; }
                        else *(f32x4*)(out + off + bj * HALF + n * 16) = y; } }
    }
};
}
#define XB_TMO      128
#define XB_XCNT(j)  (256  + 64 * (j))
#define XB_XSUB(j)  (1280 + 64 * (j))
#define XB_XGEN(j)  (2304 + 64 * (j))
#define XB_TOP      3328
#define XB_TOPGEN   3392
#define XCD_BAR_WORDS 3456
#define XB_SPIN_CAP (1u << 18)

__device__ __forceinline__ unsigned xb_ld(unsigned* p)              { return __hip_atomic_load(p, __ATOMIC_RELAXED, __HIP_MEMORY_SCOPE_AGENT); }
__device__ __forceinline__ unsigned xb_add(unsigned* p, unsigned v) { return __hip_atomic_fetch_add(p, v, __ATOMIC_RELAXED, __HIP_MEMORY_SCOPE_AGENT); }
__device__ __forceinline__ unsigned xb_xcc_id() { return (unsigned)__builtin_amdgcn_s_getreg((3 << 11) | 20) & 0xFu; }
#define XB_SPIN(cond, bar) do { unsigned _sp = 0; while (cond) { __builtin_amdgcn_s_sleep(1); \
    if ((++_sp & 255u) == 0u) { if (xb_ld(&(bar)[XB_TMO])) break; if (_sp > XB_SPIN_CAP) { atomicAdd(&(bar)[XB_TMO], 1u); break; } } } } while (0)

struct XcdBarrier {
    unsigned* bar; unsigned x;
    volatile LAS unsigned* st;
};

__device__ __forceinline__ XcdBarrier xcd_barrier_post(unsigned* bar, volatile LAS unsigned* st) {
    XcdBarrier b; b.bar = bar; b.x = xb_xcc_id(); b.st = st;
    if (threadIdx.x == 0) (void)xb_add(&bar[XB_XCNT(b.x)], 1u);
    return b;
}
__device__ __forceinline__ void xcd_barrier_complete(unsigned* bar, unsigned x, unsigned& nloc, unsigned& nx) {
    const unsigned G = gridDim.x * gridDim.y * gridDim.z;
    unsigned sum, cnt, mine, sp = 0u;
    for (;;) {
        sum = 0u; cnt = 0u; mine = 0u;
#pragma unroll
        for (unsigned j = 0; j < 16; ++j) { const unsigned c = xb_ld(&bar[XB_XCNT(j)]); sum += c; cnt += (c > 0u) ? 1u : 0u; mine = (j == x) ? c : mine; }
        if (sum == G) break;
        __builtin_amdgcn_s_sleep(1);
        if ((++sp & 255u) == 0u) { if (xb_ld(&bar[XB_TMO])) break; if (sp > XB_SPIN_CAP) { atomicAdd(&bar[XB_TMO], 1u); break; } }
    }
    nloc = mine > 0u ? mine : 1u; nx = cnt > 0u ? cnt : 1u;
}

__device__ __forceinline__ void xcd_barrier(const XcdBarrier& b) {
    asm volatile("s_waitcnt vmcnt(0)" ::: "memory");
    __syncthreads();
    if (threadIdx.x == 0) {
        unsigned* bar = b.bar;
        __builtin_amdgcn_s_waitcnt(0);
        unsigned nloc = b.st[0], nx = b.st[1];
        if (nloc == 0u) { xcd_barrier_complete(bar, b.x, nloc, nx); b.st[0] = nloc; b.st[1] = nx; }
        const unsigned old = xb_add(&bar[XB_XSUB(b.x)], 1u);
        const unsigned gen = old / nloc;
        if (old + 1u == (gen + 1u) * nloc) {
            __builtin_amdgcn_fence(__ATOMIC_RELEASE, "agent");
            asm volatile("s_waitcnt vmcnt(0)" ::: "memory");
            const unsigned og = xb_add(&bar[XB_TOP], 1u);
            const unsigned tg = og / nx;
            if (og + 1u == (tg + 1u) * nx) xb_add(&bar[XB_TOPGEN], 1u);
            else XB_SPIN(xb_ld(&bar[XB_TOPGEN]) == tg, bar);
            __builtin_amdgcn_fence(__ATOMIC_ACQUIRE, "agent");
            xb_add(&bar[XB_XGEN(b.x)], 1u);
            asm volatile("s_waitcnt vmcnt(0)" ::: "memory");
        } else {
            XB_SPIN(xb_ld(&bar[XB_XGEN(b.x)]) == gen, bar);
            __builtin_amdgcn_fence(__ATOMIC_ACQUIRE, "agent");
            asm volatile("s_waitcnt vmcnt(0)" ::: "memory");
        }
    }
    __syncthreads();
}

typedef short bf16x8_t __attribute__((ext_vector_type(8)));
typedef float f32x16 __attribute__((ext_vector_type(16)));
#define MFMA32(a, b, c) __builtin_amdgcn_mfma_f32_32x32x16_bf16((a), (b), (c), 0, 0, 0)
typedef float f32x2_t __attribute__((ext_vector_type(2))); typedef __bf16 bf16x2_t __attribute__((ext_vector_type(2)));
__device__ __forceinline__ unsigned cvtpk(float lo, float hi) { f32x2_t v = {lo, hi}; bf16x2_t b = __builtin_convertvector(v, bf16x2_t); return __builtin_bit_cast(unsigned, b); }
constexpr int FOX_ROWB = 144, FOX_KB = 64 * FOX_ROWB, FOX_BUF = 2 * FOX_KB + 256;
template <int MODE>
__device__ __forceinline__ void fox_unit(const bf16* PROJ, const float* GATES, bf16* MIX, LAS unsigned char* lds, int b, int h, int qb, int tid, int lane, int wave) {
    constexpr float C2 = 0.125f * 1.4426950408889634f, L2E = 1.4426950408889634f;
    constexpr int NP = MODE == 0 ? NP1 : NP0, QC = MODE == 0 ? 1536 : 0, KC = MODE == 0 ? 2048 : 512, VC = MODE == 0 ? 2560 : 1024, OC = MODE == 0 ? 512 : 0;
    LAS float* biasl = (LAS float*)(lds + 2 * FOX_BUF);
    const int q = lane & 31, hi = lane >> 5;
    const size_t rowbase = (size_t)b * SEQ;
    const int q0 = qb * 256, qrow = q0 + wave * 32 + q;
    const int NT = 4 * qb + 4, T0 = MODE == 0 ? 0 : (4 * qb - 8 < 0 ? 0 : 4 * qb - 8);
    const bool isV = tid < 256;
    const int sidx = tid & 255, sr = sidx >> 3, sc = sidx & 7;
    const bf16* gK = PROJ + (rowbase + sr) * NP + KC + h * 64 + sc * 8;
    const bf16* gV = PROJ + (rowbase + 2 * sr) * NP + VC + h * 64 + sc * 8;
    const float* gF = GATES + (rowbase + tid) * 16 + 8 + h;
    u32x4 st0[2], st1[2]; float stf[2] = {0.f, 0.f};
#define FOX_LOAD(t, k) do { const size_t off = (size_t)(t) * 64 * NP; \
        if (isV) { st0[k] = *(const u32x4*)(gV + off); st1[k] = *(const u32x4*)(gV + off + NP); } \
        else { st0[k] = *(const u32x4*)(gK + off); st1[k] = *(const u32x4*)(gK + off + (size_t)32 * NP); } \
        if (MODE == 0 && tid < 64) stf[k] = gF[(size_t)(t) * 64 * 16]; } while (0)
#define FOX_STORE(buf, k) do { LAS unsigned char* B_ = lds + (buf) * FOX_BUF; const u32x4 A_ = st0[k], C_ = st1[k]; \
        if (isV) { LAS unsigned char* vt = B_ + FOX_KB + (8 * sc) * FOX_ROWB + 4 * sr; \
            *(LAS unsigned*)(vt + 0 * FOX_ROWB) = (A_.x & 0xffffu) | (C_.x << 16); *(LAS unsigned*)(vt + 1 * FOX_ROWB) = (A_.x >> 16) | (C_.x & 0xffff0000u); \
            *(LAS unsigned*)(vt + 2 * FOX_ROWB) = (A_.y & 0xffffu) | (C_.y << 16); *(LAS unsigned*)(vt + 3 * FOX_ROWB) = (A_.y >> 16) | (C_.y & 0xffff0000u); \
            *(LAS unsigned*)(vt + 4 * FOX_ROWB) = (A_.z & 0xffffu) | (C_.z << 16); *(LAS unsigned*)(vt + 5 * FOX_ROWB) = (A_.z >> 16) | (C_.z & 0xffff0000u); \
            *(LAS unsigned*)(vt + 6 * FOX_ROWB) = (A_.w & 0xffffu) | (C_.w << 16); *(LAS unsigned*)(vt + 7 * FOX_ROWB) = (A_.w >> 16) | (C_.w & 0xffff0000u); } \
        else { *(LAS u32x4*)(B_ + sr * FOX_ROWB + 16 * sc) = A_; *(LAS u32x4*)(B_ + (sr + 32) * FOX_ROWB + 16 * sc) = C_; } \
        if (MODE == 0 && tid < 64) *(LAS float*)(B_ + 2 * FOX_KB + 4 * tid) = -stf[k] * L2E; } while (0)
    FOX_LOAD(T0, 0);
    if (MODE == 1) { for (int i = tid; i < 513; i += NTHR) biasl[i] = GATES[h * 513 + i] * L2E; }
    bf16x8_t qr[4];
    { const bf16* qp = PROJ + (rowbase + qrow) * NP + QC + h * 64 + 8 * hi;
#pragma unroll
      for (int d0 = 0; d0 < 4; ++d0) qr[d0] = *(const bf16x8_t*)(qp + 16 * d0); }
    f32x16 o0, o1;
#pragma unroll
    for (int i = 0; i < 16; ++i) { o0[i] = 0.f; o1[i] = 0.f; }
    float m_ref = MODE == 0 ? -GATES[(rowbase + qrow) * 16 + 8 + h] * L2E : 0.f, l_run = 0.f;
    f32x16 negm;
#pragma unroll
    for (int i = 0; i < 16; ++i) negm[i] = -m_ref * (1.f / C2);
    FOX_STORE(T0 & 1, 0);
    FOX_LOAD(T0 + 1, 0); FOX_LOAD(T0 + 2, 1);
    LDS_BARRIER();
    const int nq = 4 * qb + (wave >> 1);
    bool fresh = true;
    for (int t2 = T0; t2 < NT; t2 += 2) {
#pragma unroll
      for (int k = 0; k < 2; ++k) {
        const int t = t2 + k;
        if (t < NT) {
        if (t + 1 < NT) FOX_STORE((t + 1) & 1, k);
        if (t + 3 < NT) FOX_LOAD(t + 3, k);
        const int s0 = t * 64;
        if (MODE == 0 ? (s0 <= q0 + wave * 32 + 31) : (t >= nq - 8 && t <= nq)) {
            const LAS unsigned char* Kl = lds + (t & 1) * FOX_BUF; const LAS unsigned char* Vl = Kl + FOX_KB; const LAS float* kbl = (const LAS float*)(Kl + 2 * FOX_KB);
            f32x16 p0, p1;
#pragma unroll
            for (int d0 = 0; d0 < 4; ++d0) {
                const bf16x8_t a0 = *(const LAS bf16x8_t*)(Kl + q * FOX_ROWB + (16 * d0 + 8 * hi) * 2);
                const bf16x8_t a1 = *(const LAS bf16x8_t*)(Kl + (32 + q) * FOX_ROWB + (16 * d0 + 8 * hi) * 2);
                if (d0 == 0) { p0 = MFMA32(a0, qr[0], negm); p1 = MFMA32(a1, qr[0], negm); }
                else { p0 = MFMA32(a0, qr[d0], p0); p1 = MFMA32(a1, qr[d0], p1); }
            }
            float mt = -INFINITY;
            const bool need_mask = (s0 + 63 > q0 + wave * 32);
#pragma unroll
            for (int g = 0; g < 4; ++g) {
                if (MODE == 0) {
                    const f32x4 k0 = *(const LAS f32x4*)(kbl + 8 * g + 4 * hi), k1 = *(const LAS f32x4*)(kbl + 32 + 8 * g + 4 * hi);
#pragma unroll
                    for (int j = 0; j < 4; ++j) {
                        float x0 = p0[4 * g + j] * C2 + k0[j], x1 = p1[4 * g + j] * C2 + k1[j];
                        if (need_mask) { const int kv = s0 + 8 * g + 4 * hi + j; if (kv > qrow) x0 = -INFINITY; if (kv + 32 > qrow) x1 = -INFINITY; }
                        p0[4 * g + j] = x0; p1[4 * g + j] = x1; mt = fmaxf(mt, fmaxf(x0, x1));
                    }
                } else {
#pragma unroll
                    for (int j = 0; j < 4; ++j) {
                        int d0 = qrow - (s0 + 8 * g + 4 * hi + j) + 256, d1 = d0 - 32;
                        d0 = d0 < 0 ? 0 : (d0 > 512 ? 512 : d0); d1 = d1 < 0 ? 0 : (d1 > 512 ? 512 : d1);
                        const float x0 = p0[4 * g + j] * C2 + biasl[d0], x1 = p1[4 * g + j] * C2 + biasl[d1];
                        p0[4 * g + j] = x0; p1[4 * g + j] = x1; mt = fmaxf(mt, fmaxf(x0, x1));
                    }
                }
            }
            mt = fmaxf(mt, __shfl_xor(mt, 32));
            if (fresh) {
                fresh = false;
                const float dl = mt > -1e30f ? mt : 0.f;
                m_ref += dl;
#pragma unroll
                for (int i = 0; i < 16; ++i) { p0[i] -= dl; p1[i] -= dl; negm[i] = -m_ref * (1.f / C2); }
            } else if (__any(mt > 6.0f)) {
                const float dl = fmaxf(mt, 0.f), fac = __builtin_amdgcn_exp2f(-dl);
                m_ref += dl; l_run *= fac;
#pragma unroll
                for (int i = 0; i < 16; ++i) { p0[i] -= dl; p1[i] -= dl; o0[i] *= fac; o1[i] *= fac; negm[i] = -m_ref * (1.f / C2); }
            }
            float ls = 0.f;
#pragma unroll
            for (int i = 0; i < 16; ++i) { p0[i] = __builtin_amdgcn_exp2f(p0[i]); p1[i] = __builtin_amdgcn_exp2f(p1[i]); ls += p0[i] + p1[i]; }
            l_run += ls;
            bf16x8_t pf[4];
#pragma unroll
            for (int s = 0; s < 2; ++s) {
                u32x4 w; w.x = cvtpk(p0[8 * s], p0[8 * s + 1]); w.y = cvtpk(p0[8 * s + 2], p0[8 * s + 3]); w.z = cvtpk(p0[8 * s + 4], p0[8 * s + 5]); w.w = cvtpk(p0[8 * s + 6], p0[8 * s + 7]);
                pf[s] = __builtin_bit_cast(bf16x8_t, w);
                u32x4 w2; w2.x = cvtpk(p1[8 * s], p1[8 * s + 1]); w2.y = cvtpk(p1[8 * s + 2], p1[8 * s + 3]); w2.z = cvtpk(p1[8 * s + 4], p1[8 * s + 5]); w2.w = cvtpk(p1[8 * s + 6], p1[8 * s + 7]);
                pf[2 + s] = __builtin_bit_cast(bf16x8_t, w2);
            }
#pragma unroll
            for (int ks = 0; ks < 4; ++ks) {
                const LAS unsigned char* vp = Vl + q * FOX_ROWB + (16 * ks + 4 * hi) * 2;
                const u32x2 a = *(const LAS u32x2*)(vp), c = *(const LAS u32x2*)(vp + 16);
                const u32x2 a2 = *(const LAS u32x2*)(vp + 32 * FOX_ROWB), c2 = *(const LAS u32x2*)(vp + 32 * FOX_ROWB + 16);
                u32x4 v0; v0.x = a.x; v0.y = a.y; v0.z = c.x; v0.w = c.y;
                u32x4 v1; v1.x = a2.x; v1.y = a2.y; v1.z = c2.x; v1.w = c2.y;
                o0 = MFMA32(__builtin_bit_cast(bf16x8_t, v0), pf[ks], o0);
                o1 = MFMA32(__builtin_bit_cast(bf16x8_t, v1), pf[ks], o1);
            }
        }
        LDS_BARRIER();
        }
      }
    }
    l_run += __shfl_xor(l_run, 32);
    const float il = 1.f / l_run;
    bf16* op = MIX + (rowbase + qrow) * 1024 + OC + h * 64 + 4 * hi;
#pragma unroll
    for (int g = 0; g < 4; ++g) {
        u32x2 w; w.x = pk2(o0[4 * g] * il, o0[4 * g + 1] * il); w.y = pk2(o0[4 * g + 2] * il, o0[4 * g + 3] * il); *(u32x2*)(op + 8 * g) = w;
        u32x2 w2; w2.x = pk2(o1[4 * g] * il, o1[4 * g + 1] * il); w2.y = pk2(o1[4 * g + 2] * il, o1[4 * g + 3] * il); *(u32x2*)(op + 32 + 8 * g) = w2;
    }
#undef FOX_LOAD
#undef FOX_STORE
}

__device__ __forceinline__ void band_fast_phase(const bf16* PROJ, const float* relb, bf16* MIX, LAS unsigned char* lds, int bid, int b_lo, int G, int tid, int lane, int wave) {
    if (bid < b_lo) return;
    for (int u = bid - b_lo; u < 512; u += G - b_lo) {
        const int bh = u >> 5, qb = u & 31;
        fox_unit<1>(PROJ, relb, MIX, lds, bh >> 3, bh & 7, qb, tid, lane, wave);
    }
}


__device__ __forceinline__ void fox_unit_acp(const bf16* PROJ, const float* GATES, const unsigned* KN2, bf16* MIX, LAS unsigned char* lds, int b, int h, int qb, int tid, int lane, int wave) {
    constexpr float C2 = 0.125f * 1.4426950408889634f, L2E = 1.4426950408889634f;
    constexpr int NP = NP1, QC = 1536, KC = 2048, VC = 2560, OC = 512;
    LAS unsigned* votes = (LAS unsigned*)(lds + 2 * FOX_BUF);
    const int q = lane & 31, hi = lane >> 5;
    const size_t rowbase = (size_t)b * SEQ;
    const int q0 = qb * 256, qrow = q0 + wave * 32 + q;
    const int NT = 4 * qb + 4;
    const bool isV = tid < 256;
    const int sidx = tid & 255, sr = sidx >> 3, sc = sidx & 7;
    const bf16* gK = PROJ + (rowbase + sr) * NP + KC + h * 64 + sc * 8;
    const bf16* gV = PROJ + (rowbase + 2 * sr) * NP + VC + h * 64 + sc * 8;
    const float* gF = GATES + (rowbase + tid) * 16 + 8 + h;
    const float* Fh = GATES + rowbase * 16 + 8 + h;
    u32x4 st0, st1; float stf = 0.f;
#define ACP_LOAD(t) do { const size_t off = (size_t)(t) * 64 * NP; \
        if (isV) { st0 = *(const u32x4*)(gV + off); st1 = *(const u32x4*)(gV + off + NP); } \
        else { st0 = *(const u32x4*)(gK + off); st1 = *(const u32x4*)(gK + off + (size_t)32 * NP); } \
        if (tid < 64) stf = gF[(size_t)(t) * 64 * 16]; } while (0)
#define ACP_STORE(buf) do { LAS unsigned char* B_ = lds + (buf) * FOX_BUF; \
        if (isV) { LAS unsigned char* vt = B_ + FOX_KB + (8 * sc) * FOX_ROWB + 4 * sr; \
            *(LAS unsigned*)(vt + 0 * FOX_ROWB) = (st0.x & 0xffffu) | (st1.x << 16); *(LAS unsigned*)(vt + 1 * FOX_ROWB) = (st0.x >> 16) | (st1.x & 0xffff0000u); \
            *(LAS unsigned*)(vt + 2 * FOX_ROWB) = (st0.y & 0xffffu) | (st1.y << 16); *(LAS unsigned*)(vt + 3 * FOX_ROWB) = (st0.y >> 16) | (st1.y & 0xffff0000u); \
            *(LAS unsigned*)(vt + 4 * FOX_ROWB) = (st0.z & 0xffffu) | (st1.z << 16); *(LAS unsigned*)(vt + 5 * FOX_ROWB) = (st0.z >> 16) | (st1.z & 0xffff0000u); \
            *(LAS unsigned*)(vt + 6 * FOX_ROWB) = (st0.w & 0xffffu) | (st1.w << 16); *(LAS unsigned*)(vt + 7 * FOX_ROWB) = (st0.w >> 16) | (st1.w & 0xffff0000u); } \
        else { *(LAS u32x4*)(B_ + sr * FOX_ROWB + 16 * sc) = st0; *(LAS u32x4*)(B_ + (sr + 32) * FOX_ROWB + 16 * sc) = st1; } \
        if (tid < 64) *(LAS float*)(B_ + 2 * FOX_KB + 4 * tid) = -stf * L2E; } while (0)
    ACP_LOAD(NT - 1);
    bf16x8_t qr[4];
    { const bf16* qp = PROJ + (rowbase + qrow) * NP + QC + h * 64 + 8 * hi;
#pragma unroll
      for (int d0 = 0; d0 < 4; ++d0) qr[d0] = *(const bf16x8_t*)(qp + 16 * d0); }
    float qub;
    { float s2 = 0.f;
#pragma unroll
      for (int d0 = 0; d0 < 4; ++d0) { const u32x4 w = __builtin_bit_cast(u32x4, qr[d0]);
          s2 += bflo(w.x) * bflo(w.x) + bfhi(w.x) * bfhi(w.x) + bflo(w.y) * bflo(w.y) + bfhi(w.y) * bfhi(w.y) + bflo(w.z) * bflo(w.z) + bfhi(w.z) * bfhi(w.z) + bflo(w.w) * bflo(w.w) + bfhi(w.w) * bfhi(w.w); }
      s2 += __shfl_xor(s2, 32);
      qub = sqrtf(s2) * sqrtf(__uint_as_float(KN2[b * 8 + h])) * C2 * 1.01f + 0.01f; }
    const float Ft2 = GATES[(rowbase + qrow) * 16 + 8 + h] * L2E;
    f32x16 o0, o1;
#pragma unroll
    for (int i = 0; i < 16; ++i) { o0[i] = 0.f; o1[i] = 0.f; }
    float m_ref = -Ft2, l_run = 0.f, mrow = -INFINITY;
    f32x16 negm;
#pragma unroll
    for (int i = 0; i < 16; ++i) negm[i] = -m_ref * (1.f / C2);
    ACP_STORE(0);
    LDS_BARRIER();
    int it = 0; bool fresh = true;
    for (int t = NT - 1; t >= 0; --t, ++it) {
        float Fnext = 0.f;
        if (t > 0) { ACP_LOAD(t - 1); Fnext = Fh[(size_t)((t - 1) * 64 + 63) * 16]; }
        const int s0 = t * 64;
        if (s0 <= q0 + wave * 32 + 31) {
            const LAS unsigned char* Kl = lds + (it & 1) * FOX_BUF; const LAS unsigned char* Vl = Kl + FOX_KB; const LAS float* kbl = (const LAS float*)(Kl + 2 * FOX_KB);
            f32x16 p0, p1;
#pragma unroll
            for (int d0 = 0; d0 < 4; ++d0) {
                const bf16x8_t a0 = *(const LAS bf16x8_t*)(Kl + q * FOX_ROWB + (16 * d0 + 8 * hi) * 2);
                const bf16x8_t a1 = *(const LAS bf16x8_t*)(Kl + (32 + q) * FOX_ROWB + (16 * d0 + 8 * hi) * 2);
                if (d0 == 0) { p0 = MFMA32(a0, qr[0], negm); p1 = MFMA32(a1, qr[0], negm); }
                else { p0 = MFMA32(a0, qr[d0], p0); p1 = MFMA32(a1, qr[d0], p1); }
            }
            float mt = -INFINITY;
            const bool need_mask = (s0 + 63 > q0 + wave * 32);
#pragma unroll
            for (int g = 0; g < 4; ++g) {
                const f32x4 k0 = *(const LAS f32x4*)(kbl + 8 * g + 4 * hi), k1 = *(const LAS f32x4*)(kbl + 32 + 8 * g + 4 * hi);
#pragma unroll
                for (int j = 0; j < 4; ++j) {
                    float x0 = p0[4 * g + j] * C2 + k0[j], x1 = p1[4 * g + j] * C2 + k1[j];
                    if (need_mask) { const int kv = s0 + 8 * g + 4 * hi + j; if (kv > qrow) x0 = -INFINITY; if (kv + 32 > qrow) x1 = -INFINITY; }
                    p0[4 * g + j] = x0; p1[4 * g + j] = x1; mt = fmaxf(mt, fmaxf(x0, x1));
                }
            }
            mt = fmaxf(mt, __shfl_xor(mt, 32));
            mrow = fmaxf(mrow, mt);
            if (fresh) {
                fresh = false;
                const float dl = mt > -1e30f ? mt : 0.f;
                m_ref += dl; mrow -= dl;
#pragma unroll
                for (int i = 0; i < 16; ++i) { p0[i] -= dl; p1[i] -= dl; negm[i] = -m_ref * (1.f / C2); }
            } else if (__any(mt > 6.0f)) {
                const float dl = fmaxf(mt, 0.f), fac = __builtin_amdgcn_exp2f(-dl);
                m_ref += dl; l_run *= fac; mrow -= dl;
#pragma unroll
                for (int i = 0; i < 16; ++i) { p0[i] -= dl; p1[i] -= dl; o0[i] *= fac; o1[i] *= fac; negm[i] = -m_ref * (1.f / C2); }
            }
            float ls = 0.f;
#pragma unroll
            for (int i = 0; i < 16; ++i) { p0[i] = __builtin_amdgcn_exp2f(p0[i]); p1[i] = __builtin_amdgcn_exp2f(p1[i]); ls += p0[i] + p1[i]; }
            l_run += ls;
            bf16x8_t pf[4];
#pragma unroll
            for (int s = 0; s < 2; ++s) {
                u32x4 w; w.x = cvtpk(p0[8 * s], p0[8 * s + 1]); w.y = cvtpk(p0[8 * s + 2], p0[8 * s + 3]); w.z = cvtpk(p0[8 * s + 4], p0[8 * s + 5]); w.w = cvtpk(p0[8 * s + 6], p0[8 * s + 7]);
                pf[s] = __builtin_bit_cast(bf16x8_t, w);
                u32x4 w2; w2.x = cvtpk(p1[8 * s], p1[8 * s + 1]); w2.y = cvtpk(p1[8 * s + 2], p1[8 * s + 3]); w2.z = cvtpk(p1[8 * s + 4], p1[8 * s + 5]); w2.w = cvtpk(p1[8 * s + 6], p1[8 * s + 7]);
                pf[2 + s] = __builtin_bit_cast(bf16x8_t, w2);
            }
#pragma unroll
            for (int ks = 0; ks < 4; ++ks) {
                const LAS unsigned char* vp = Vl + q * FOX_ROWB + (16 * ks + 4 * hi) * 2;
                const u32x2 a = *(const LAS u32x2*)(vp), c = *(const LAS u32x2*)(vp + 16);
                const u32x2 a2 = *(const LAS u32x2*)(vp + 32 * FOX_ROWB), c2 = *(const LAS u32x2*)(vp + 32 * FOX_ROWB + 16);
                u32x4 v0; v0.x = a.x; v0.y = a.y; v0.z = c.x; v0.w = c.y;
                u32x4 v1; v1.x = a2.x; v1.y = a2.y; v1.z = c2.x; v1.w = c2.y;
                o0 = MFMA32(__builtin_bit_cast(bf16x8_t, v0), pf[ks], o0);
                o1 = MFMA32(__builtin_bit_cast(bf16x8_t, v1), pf[ks], o1);
            }
        }
        if (t == 0) break;
        { const float xub = qub - Fnext * L2E - m_ref;
          const bool drop = xub < mrow - 40.0f;
          const unsigned v = __all(drop) ? 1u : 0u;
          if (lane == 0) votes[(it & 1) * 8 + wave] = v; }
        ACP_STORE((it + 1) & 1);
        LDS_BARRIER();
        { const LAS unsigned* vv = votes + (it & 1) * 8;
          const unsigned all = vv[0] & vv[1] & vv[2] & vv[3] & vv[4] & vv[5] & vv[6] & vv[7];
          if (all) break; }
    }
    LDS_BARRIER();
    l_run += __shfl_xor(l_run, 32);
    const float il = 1.f / l_run;
    bf16* op = MIX + (rowbase + qrow) * 1024 + OC + h * 64 + 4 * hi;
#pragma unroll
    for (int g = 0; g < 4; ++g) {
        u32x2 w; w.x = pk2(o0[4 * g] * il, o0[4 * g + 1] * il); w.y = pk2(o0[4 * g + 2] * il, o0[4 * g + 3] * il); *(u32x2*)(op + 8 * g) = w;
        u32x2 w2; w2.x = pk2(o1[4 * g] * il, o1[4 * g + 1] * il); w2.y = pk2(o1[4 * g + 2] * il, o1[4 * g + 3] * il); *(u32x2*)(op + 32 + 8 * g) = w2;
    }
#undef ACP_LOAD
#undef ACP_STORE
}
__device__ __forceinline__ void fox_acp_phase(const bf16* PROJ, const float* GATES, const unsigned* KN2, bf16* MIX, LAS unsigned char* lds, int bid, int G, int tid, int lane, int wave) {
    for (int u = bid; u < 512; u += G) {
        const int bh = u & 15, qb = 31 - (u >> 4);
        fox_unit_acp(PROJ, GATES, KN2, MIX, lds, bh >> 3, bh & 7, qb, tid, lane, wave);
    }
}

constexpr int SSD_ROWB = 144, SSD_XT = 512 * SSD_ROWB, SSD_BT = 256 * SSD_ROWB;
__device__ __forceinline__ float wave_incl_scan(float v, int lane) {
#pragma unroll
    for (int o = 1; o < 64; o <<= 1) { const float t = __shfl_up(v, o); if (lane >= o) v += t; }
    return v;
}
__device__ __forceinline__ void ssd_states_phase(const bf16* PROJ, const float* convw, const float* convb, bf16* XBC, const float* GATES, const float* a_log, bf16* ST, float* DEC, unsigned* KN2,
                                                 LAS unsigned char* lds, int bid, int G, int tid, int lane, int wave) {
    LAS unsigned char* xwT = lds; LAS unsigned char* BT = lds + SSD_XT; LAS float* wl = (LAS float*)(lds + SSD_XT + SSD_BT);
    const int h = wave, g = h >> 2, q = lane & 31, hi = lane >> 5;
    const float a = -__expf(a_log[h]);
    for (int ch = bid; ch < 256; ch += G) {
        const size_t m0 = (size_t)ch * 64;
        const int t0c = (ch & 127) * 64;
        { const float dtl = GATES[(m0 + lane) * 16 + h]; const float v = wave_incl_scan(dtl * a, lane); const float tot = __shfl(v, 63);
          wl[h * 64 + lane] = __expf(tot - v) * dtl; if (lane == 63) DEC[ch * 8 + h] = __expf(tot); }
        {
            const int r = tid >> 3, hh = tid & 7; const u32x4* kp = (const u32x4*)(PROJ + (m0 + r) * NP1 + 2048 + hh * 64); float s2 = 0.f;
#pragma unroll
            for (int i = 0; i < 8; ++i) { const u32x4 w = kp[i]; s2 += bflo(w.x) * bflo(w.x) + bfhi(w.x) * bfhi(w.x) + bflo(w.y) * bflo(w.y) + bfhi(w.y) * bfhi(w.y) + bflo(w.z) * bflo(w.z) + bfhi(w.z) * bfhi(w.z) + bflo(w.w) * bflo(w.w) + bfhi(w.w) * bfhi(w.w); }
            s2 = fmaxf(s2, __shfl_xor(s2, 8)); s2 = fmaxf(s2, __shfl_xor(s2, 16)); s2 = fmaxf(s2, __shfl_xor(s2, 32));
            if (lane < 8) wl[512 + wave * 8 + hh] = s2; }
        __syncthreads();
        if (tid < 8) {
            float m8 = wl[512 + tid];
#pragma unroll
            for (int w = 1; w < 8; ++w) m8 = fmaxf(m8, wl[512 + w * 8 + tid]);
            unsigned* kp = KN2 + (ch >> 7) * 8 + tid; const unsigned bits = __float_as_uint(m8);
            if (__hip_atomic_load(kp, __ATOMIC_RELAXED, __HIP_MEMORY_SCOPE_AGENT) < bits) atomicMax(kp, bits);
        }
#pragma unroll 1
        for (int k = 0; k < 2; ++k) {
            const int blk = tid + NTHR * k, rb8 = blk >> 7, cg = blk & 127, c0 = 8 * cg;
            const bf16* src = PROJ + (m0 + 8 * rb8) * NP1 + 512 + c0;
            u32x4 xr[11];
#pragma unroll
            for (int r = 0; r < 11; ++r) { if (t0c + 8 * rb8 + r - 3 >= 0) xr[r] = *(const u32x4*)(src + (ptrdiff_t)(r - 3) * NP1); else xr[r] = (u32x4){0u, 0u, 0u, 0u}; }
            float w[4][8], bb[8];
#pragma unroll
            for (int j = 0; j < 4; ++j) { const f32x4 aa = *(const f32x4*)(convw + j * 1024 + c0), cc = *(const f32x4*)(convw + j * 1024 + c0 + 4);
                w[j][0] = aa.x; w[j][1] = aa.y; w[j][2] = aa.z; w[j][3] = aa.w; w[j][4] = cc.x; w[j][5] = cc.y; w[j][6] = cc.z; w[j][7] = cc.w; }
            { const f32x4 aa = *(const f32x4*)(convb + c0), cc = *(const f32x4*)(convb + c0 + 4); bb[0] = aa.x; bb[1] = aa.y; bb[2] = aa.z; bb[3] = aa.w; bb[4] = cc.x; bb[5] = cc.y; bb[6] = cc.z; bb[7] = cc.w; }
#pragma unroll
            for (int pr = 0; pr < 4; ++pr) {
                float v0[8], v1[8], f[8];
#pragma unroll
                for (int i = 0; i < 8; ++i) { v0[i] = bb[i]; v1[i] = bb[i]; }
#pragma unroll
                for (int j = 0; j < 4; ++j) { unpack8(xr[2 * pr + j], f);
#pragma unroll
                    for (int i = 0; i < 8; ++i) v0[i] += w[j][i] * f[i];
                    unpack8(xr[2 * pr + 1 + j], f);
#pragma unroll
                    for (int i = 0; i < 8; ++i) v1[i] += w[j][i] * f[i]; }
#pragma unroll
                for (int i = 0; i < 8; ++i) { v0[i] = silu_f(v0[i]); v1[i] = silu_f(v1[i]); }
                const int r0 = 8 * rb8 + 2 * pr;
                u32x4 o0; o0.x = pk2(v0[0], v0[1]); o0.y = pk2(v0[2], v0[3]); o0.z = pk2(v0[4], v0[5]); o0.w = pk2(v0[6], v0[7]);
                u32x4 o1; o1.x = pk2(v1[0], v1[1]); o1.y = pk2(v1[2], v1[3]); o1.z = pk2(v1[4], v1[5]); o1.w = pk2(v1[6], v1[7]);
                *(u32x4*)(XBC + (m0 + r0) * 1024 + c0) = o0; *(u32x4*)(XBC + (m0 + r0 + 1) * 1024 + c0) = o1;
                if (cg < 64) {
                    const int hh = cg >> 3; const float w0 = wl[hh * 64 + r0], w1 = wl[hh * 64 + r0 + 1];
                    LAS unsigned char* d = xwT + c0 * SSD_ROWB + 2 * r0;
                    *(LAS unsigned*)(d + 0 * SSD_ROWB) = pk2(bflo(o0.x) * w0, bflo(o1.x) * w1); *(LAS unsigned*)(d + 1 * SSD_ROWB) = pk2(bfhi(o0.x) * w0, bfhi(o1.x) * w1);
                    *(LAS unsigned*)(d + 2 * SSD_ROWB) = pk2(bflo(o0.y) * w0, bflo(o1.y) * w1); *(LAS unsigned*)(d + 3 * SSD_ROWB) = pk2(bfhi(o0.y) * w0, bfhi(o1.y) * w1);
                    *(LAS unsigned*)(d + 4 * SSD_ROWB) = pk2(bflo(o0.z) * w0, bflo(o1.z) * w1); *(LAS unsigned*)(d + 5 * SSD_ROWB) = pk2(bfhi(o0.z) * w0, bfhi(o1.z) * w1);
                    *(LAS unsigned*)(d + 6 * SSD_ROWB) = pk2(bflo(o0.w) * w0, bflo(o1.w) * w1); *(LAS unsigned*)(d + 7 * SSD_ROWB) = pk2(bfhi(o0.w) * w0, bfhi(o1.w) * w1);
                } else if (cg < 96) {
                    LAS unsigned char* d = BT + (c0 - 512) * SSD_ROWB + 2 * r0;
                    *(LAS unsigned*)(d + 0 * SSD_ROWB) = (o0.x & 0xffffu) | (o1.x << 16); *(LAS unsigned*)(d + 1 * SSD_ROWB) = (o0.x >> 16) | (o1.x & 0xffff0000u);
                    *(LAS unsigned*)(d + 2 * SSD_ROWB) = (o0.y & 0xffffu) | (o1.y << 16); *(LAS unsigned*)(d + 3 * SSD_ROWB) = (o0.y >> 16) | (o1.y & 0xffff0000u);
                    *(LAS unsigned*)(d + 4 * SSD_ROWB) = (o0.z & 0xffffu) | (o1.z << 16); *(LAS unsigned*)(d + 5 * SSD_ROWB) = (o0.z >> 16) | (o1.z & 0xffff0000u);
                    *(LAS unsigned*)(d + 6 * SSD_ROWB) = (o0.w & 0xffffu) | (o1.w << 16); *(LAS unsigned*)(d + 7 * SSD_ROWB) = (o0.w >> 16) | (o1.w & 0xffff0000u);
                }
            }
        }
        __syncthreads();
        bf16* stb = ST + ((size_t)(ch * 8 + h) * 64) * 128;
#pragma unroll
        for (int nb = 0; nb < 4; ++nb)
#pragma unroll
            for (int pb = 0; pb < 2; ++pb) {
                f32x16 acc;
#pragma unroll
                for (int i = 0; i < 16; ++i) acc[i] = 0.f;
#pragma unroll
                for (int ks = 0; ks < 4; ++ks) {
                    const bf16x8_t af = *(const LAS bf16x8_t*)(BT + (g * 128 + 32 * nb + q) * SSD_ROWB + (16 * ks + 8 * hi) * 2);
                    const bf16x8_t bfr = *(const LAS bf16x8_t*)(xwT + (h * 64 + 32 * pb + q) * SSD_ROWB + (16 * ks + 8 * hi) * 2);
                    acc = MFMA32(af, bfr, acc);
                }
                bf16* o = stb + (size_t)(32 * pb + q) * 128 + 32 * nb + 4 * hi;
#pragma unroll
                for (int g4 = 0; g4 < 4; ++g4) { u32x2 w; w.x = cvtpk(acc[4 * g4], acc[4 * g4 + 1]); w.y = cvtpk(acc[4 * g4 + 2], acc[4 * g4 + 3]); *(u32x2*)(o + 8 * g4) = w; }
            }
        __syncthreads();
    }
}
__device__ __forceinline__ void ssd_scan_phase(bf16* ST, const float* DEC, int bid, int G, int tid) {
    for (int e = bid * NTHR + tid; e < 65536; e += G * NTHR) {
        const int b = e >> 15, rem = e & 32767, h = rem >> 12;
        unsigned* base = (unsigned*)(ST + (size_t)b * 128 * 65536 + (size_t)rem * 2);
        const float* dec = DEC + (size_t)b * 128 * 8 + h;
        float r0 = 0.f, r1 = 0.f;
        for (int c0 = 0; c0 < 128; c0 += 8) {
            unsigned s[8]; float dc[8];
#pragma unroll
            for (int j = 0; j < 8; ++j) { s[j] = base[(size_t)(c0 + j) * 32768]; dc[j] = dec[(c0 + j) * 8]; }
#pragma unroll
            for (int j = 0; j < 8; ++j) { base[(size_t)(c0 + j) * 32768] = pk2(r0, r1); r0 = r0 * dc[j] + bflo(s[j]); r1 = r1 * dc[j] + bfhi(s[j]); }
        }
    }
}
__device__ __forceinline__ void ssd_out_phase(const bf16* XBC, const bf16* PROJ, const float* GATES, const float* a_log, const float* d_skip, const float* nw,
                                              const bf16* ST, bf16* MIX, LAS unsigned char* lds, int bid, int G, int tid, int lane, int wave) {
    LAS unsigned char* xT = lds; LAS float* dal = (LAS float*)(lds + SSD_XT); LAS float* dtl_ = dal + 512; LAS float* red = dtl_ + 512;
    const int h = wave, g = h >> 2, q = lane & 31, hi = lane >> 5;
    const float a = -__expf(a_log[h]), dsk = d_skip[h];
    for (int ch = bid; ch < 256; ch += G) {
        const size_t m0 = (size_t)ch * 64;
        { const float dtl = GATES[(m0 + lane) * 16 + h]; const float v = wave_incl_scan(dtl * a, lane); dal[h * 64 + lane] = v; dtl_[h * 64 + lane] = dtl; }
#pragma unroll
        for (int k = 0; k < 4; ++k) {
            const int u = tid + NTHR * k, rp = u >> 6, cc = u & 63;
            const bf16* src = XBC + (m0 + 2 * rp) * 1024 + 8 * cc;
            const u32x4 s0 = *(const u32x4*)src, s1 = *(const u32x4*)(src + 1024);
            LAS unsigned char* d = xT + (8 * cc) * SSD_ROWB + 4 * rp;
            *(LAS unsigned*)(d + 0 * SSD_ROWB) = (s0.x & 0xffffu) | (s1.x << 16); *(LAS unsigned*)(d + 1 * SSD_ROWB) = (s0.x >> 16) | (s1.x & 0xffff0000u);
            *(LAS unsigned*)(d + 2 * SSD_ROWB) = (s0.y & 0xffffu) | (s1.y << 16); *(LAS unsigned*)(d + 3 * SSD_ROWB) = (s0.y >> 16) | (s1.y & 0xffff0000u);
            *(LAS unsigned*)(d + 4 * SSD_ROWB) = (s0.z & 0xffffu) | (s1.z << 16); *(LAS unsigned*)(d + 5 * SSD_ROWB) = (s0.z >> 16) | (s1.z & 0xffff0000u);
            *(LAS unsigned*)(d + 6 * SSD_ROWB) = (s0.w & 0xffffu) | (s1.w << 16); *(LAS unsigned*)(d + 7 * SSD_ROWB) = (s0.w >> 16) | (s1.w & 0xffff0000u);
        }
        __syncthreads();
        const bf16* Bg = XBC + (m0 + q) * 1024 + 512 + g * 128 + 8 * hi;
#pragma unroll 1
        for (int lb = 0; lb < 2; ++lb) {
            const int l = 32 * lb + q; const size_t m = m0 + l;
            const bf16* Cg = XBC + m * 1024 + 768 + g * 128 + 8 * hi;
            const float dl = dal[h * 64 + l];
            bf16x8_t wf[2][2];
            bf16x8_t fc[8];
            {
                f32x16 cb[2];
#pragma unroll
                for (int i = 0; i < 16; ++i) { cb[0][i] = 0.f; cb[1][i] = 0.f; }
                bf16x8_t fb0[8], fb1[8];
#pragma unroll
                for (int ks = 0; ks < 8; ++ks) { fb0[ks] = *(const bf16x8_t*)(Bg + 16 * ks); fb1[ks] = *(const bf16x8_t*)(Bg + 32 * 1024 + 16 * ks); fc[ks] = *(const bf16x8_t*)(Cg + 16 * ks); }
                asm volatile("" ::: "memory");
#pragma unroll
                for (int ks = 0; ks < 8; ++ks) { cb[0] = MFMA32(fb0[ks], fc[ks], cb[0]); cb[1] = MFMA32(fb1[ks], fc[ks], cb[1]); }
#pragma unroll
                for (int sb = 0; sb < 2; ++sb) {
#pragma unroll
                    for (int g4 = 0; g4 < 4; ++g4) {
                        const int s = 32 * sb + 8 * g4 + 4 * hi;
                        const f32x4 ds4 = *(const LAS f32x4*)(dal + h * 64 + s), dt4 = *(const LAS f32x4*)(dtl_ + h * 64 + s);
#pragma unroll
                        for (int j = 0; j < 4; ++j) { const float v = cb[sb][4 * g4 + j] * __expf(fminf(dl - ds4[j], 0.f)) * dt4[j]; cb[sb][4 * g4 + j] = (s + j <= l) ? v : 0.f; }
                    }
#pragma unroll
                    for (int s2 = 0; s2 < 2; ++s2) { u32x4 w; w.x = cvtpk(cb[sb][8 * s2], cb[sb][8 * s2 + 1]); w.y = cvtpk(cb[sb][8 * s2 + 2], cb[sb][8 * s2 + 3]);
                        w.z = cvtpk(cb[sb][8 * s2 + 4], cb[sb][8 * s2 + 5]); w.w = cvtpk(cb[sb][8 * s2 + 6], cb[sb][8 * s2 + 7]); wf[sb][s2] = __builtin_bit_cast(bf16x8_t, w); }
                }
            }
            f32x16 y[2];
#pragma unroll
            for (int i = 0; i < 16; ++i) { y[0][i] = 0.f; y[1][i] = 0.f; }
#pragma unroll
            for (int sb = 0; sb < 2; ++sb)
#pragma unroll
                for (int s2 = 0; s2 < 2; ++s2)
#pragma unroll
                    for (int pb = 0; pb < 2; ++pb) {
                        const LAS unsigned char* xp = xT + (h * 64 + 32 * pb + q) * SSD_ROWB + (32 * sb + 16 * s2 + 4 * hi) * 2;
                        const u32x2 x0 = *(const LAS u32x2*)xp, x1 = *(const LAS u32x2*)(xp + 16);
                        u32x4 xa; xa.x = x0.x; xa.y = x0.y; xa.z = x1.x; xa.w = x1.y;
                        y[pb] = MFMA32(__builtin_bit_cast(bf16x8_t, xa), wf[sb][s2], y[pb]);
                    }
            {
                f32x16 yo[2];
#pragma unroll
                for (int i = 0; i < 16; ++i) { yo[0][i] = 0.f; yo[1][i] = 0.f; }
                const bf16* Pg = ST + ((size_t)(ch * 8 + h) * 64 + q) * 128 + 8 * hi;
                bf16x8_t fp0[8], fp1[8];
#pragma unroll
                for (int ks = 0; ks < 8; ++ks) { fp0[ks] = *(const bf16x8_t*)(Pg + 16 * ks); fp1[ks] = *(const bf16x8_t*)(Pg + 32 * 128 + 16 * ks); }
                asm volatile("" ::: "memory");
#pragma unroll
                for (int ks = 0; ks < 8; ++ks) { yo[0] = MFMA32(fp0[ks], fc[ks], yo[0]); yo[1] = MFMA32(fp1[ks], fc[ks], yo[1]); }
                const float el = __expf(dl);
#pragma unroll
                for (int pb = 0; pb < 2; ++pb)
#pragma unroll
                    for (int i = 0; i < 16; ++i) y[pb][i] += el * yo[pb][i];
            }
            float ss = 0.f;
#pragma unroll
            for (int pb = 0; pb < 2; ++pb)
#pragma unroll
                for (int g4 = 0; g4 < 4; ++g4) {
                    const int pcol = h * 64 + 32 * pb + 8 * g4 + 4 * hi;
                    const u32x2 xw = *(const u32x2*)(XBC + m * 1024 + pcol), zw = *(const u32x2*)(PROJ + m * NP1 + pcol);
                    float v0 = (y[pb][4 * g4] + dsk * bflo(xw.x)) * silu_f(bflo(zw.x)), v1 = (y[pb][4 * g4 + 1] + dsk * bfhi(xw.x)) * silu_f(bfhi(zw.x));
                    float v2 = (y[pb][4 * g4 + 2] + dsk * bflo(xw.y)) * silu_f(bflo(zw.y)), v3 = (y[pb][4 * g4 + 3] + dsk * bfhi(xw.y)) * silu_f(bfhi(zw.y));
                    y[pb][4 * g4] = v0; y[pb][4 * g4 + 1] = v1; y[pb][4 * g4 + 2] = v2; y[pb][4 * g4 + 3] = v3;
                    ss += (v0 * v0 + v1 * v1) + (v2 * v2 + v3 * v3);
                }
            ss += __shfl_xor(ss, 32);
            if (hi == 0) red[h * 64 + l] = ss;
            __syncthreads();
            const float tot = (red[(4 * g) * 64 + l] + red[(4 * g + 1) * 64 + l]) + (red[(4 * g + 2) * 64 + l] + red[(4 * g + 3) * 64 + l]);
            const float rs = rsqrtf(tot * (1.f / 256.f) + 1e-6f);
#pragma unroll
            for (int pb = 0; pb < 2; ++pb)
#pragma unroll
                for (int g4 = 0; g4 < 4; ++g4) {
                    const int pcol = h * 64 + 32 * pb + 8 * g4 + 4 * hi;
                    const f32x4 w4 = *(const f32x4*)(nw + pcol);
                    u32x2 o; o.x = pk2(y[pb][4 * g4] * rs * w4.x, y[pb][4 * g4 + 1] * rs * w4.y); o.y = pk2(y[pb][4 * g4 + 2] * rs * w4.z, y[pb][4 * g4 + 3] * rs * w4.w);
                    *(u32x2*)(MIX + m * 1024 + pcol) = o;
                }
        }
        __syncthreads();
    }
}

constexpr int DFR_UNIT = 57344, DFR_NW = 0, DFR_QD = 16384, DFR_KST = 32768, DFR_ATT = 49152, DU_UNIT = 8192;
constexpr int DL_A = 0, DL_AT = 16384, DL_NW = 25600, DL_GC = 43008, DL_BETA = 43264;
__device__ __forceinline__ bf16x8_t pack8(const f32x16& x, int s) {
    u32x4 w; w.x = cvtpk(x[8 * s], x[8 * s + 1]); w.y = cvtpk(x[8 * s + 2], x[8 * s + 3]); w.z = cvtpk(x[8 * s + 4], x[8 * s + 5]); w.w = cvtpk(x[8 * s + 6], x[8 * s + 7]);
    return __builtin_bit_cast(bf16x8_t, w);
}
__device__ __forceinline__ void delta_prep_phase(const bf16* QK, const bf16* VB, const float* GATES, unsigned char* FR, unsigned char* U0, unsigned char* U1, float* GL,
                                                 LAS unsigned char* lds, int bid, int G, int tid, int lane, int wave) {
    const int half = wave >> 2, w4 = wave & 3, t4 = tid & 255;
    LAS unsigned char* lb = lds + half * 45056;
    LAS float* Al = (LAS float*)(lb + DL_A); LAS unsigned char* ATl = lb + DL_AT; LAS unsigned char* NWl = lb + DL_NW;
    LAS float* gcl = (LAS float*)(lb + DL_GC); LAS float* betal = (LAS float*)(lb + DL_BETA);
    const int q = lane & 31, hi = lane >> 5;
    for (int pair = bid; pair < 512; pair += G) {
        const int unit = (pair & 7) * 128 + (pair >> 3) * 2 + half;
        const int bh = unit >> 7, c = unit & 127, b = bh >> 2, h = bh & 3;
        const size_t m0 = (size_t)b * SEQ + c * 64;
        unsigned char* FRu = FR + (size_t)unit * DFR_UNIT;
        if (w4 == 0) { const float gc = wave_incl_scan(GATES[(m0 + lane) * 16 + 4 + h], lane); gcl[lane] = gc; betal[lane] = GATES[(m0 + lane) * 16 + h]; if (lane == 63) GL[unit] = __expf(gc); }
        __syncthreads();
#pragma unroll 1
        for (int bb = 0; bb < 2; ++bb) {
            const int ib = w4 >> 1, jb = w4 & 1;
            const bf16* Ar = QK + (m0 + 32 * ib + q) * 1024 + (bb == 0 ? 512 : 0) + h * 128 + 8 * hi;
            const bf16* Br = QK + (m0 + 32 * jb + q) * 1024 + 512 + h * 128 + 8 * hi;
            f32x16 acc;
#pragma unroll
            for (int i = 0; i < 16; ++i) acc[i] = 0.f;
            bf16x8_t fa[8], fb[8];
#pragma unroll
            for (int ks = 0; ks < 8; ++ks) { fa[ks] = *(const bf16x8_t*)(Ar + 16 * ks); fb[ks] = *(const bf16x8_t*)(Br + 16 * ks); }
            asm volatile("" ::: "memory");
#pragma unroll
            for (int ks = 0; ks < 8; ++ks) acc = MFMA32(fa[ks], fb[ks], acc);
            const int j = 32 * jb + q; const float gj = gcl[j];
#pragma unroll
            for (int g4 = 0; g4 < 4; ++g4) {
                const int i0 = 32 * ib + 8 * g4 + 4 * hi;
                const f32x4 gi4 = *(const LAS f32x4*)(gcl + i0), bi4 = *(const LAS f32x4*)(betal + i0);
#pragma unroll
                for (int r = 0; r < 4; ++r) {
                    const int i = i0 + r; const float e = __expf(fminf(gi4[r] - gj, 0.f));
                    if (bb == 0) Al[i * 64 + j] = (j < i) ? bi4[r] * acc[4 * g4 + r] * e : 0.f;
                    else *(LAS unsigned short*)(ATl + i * 144 + j * 2) = (unsigned short)f2bf((j <= i) ? acc[4 * g4 + r] * e : 0.f);
                }
            }
        }
        __syncthreads();
        {
            float x[64];
            if (t4 < 128) {
#pragma unroll
                for (int i = 0; i < 64; ++i) x[i] = bf2f(VB[(m0 + i) * 512 + h * 128 + t4]) * betal[i];
            } else {
#pragma unroll
                for (int i = 0; i < 64; ++i) x[i] = bf2f(QK[(m0 + i) * 1024 + 512 + h * 128 + (t4 - 128)]) * betal[i] * __expf(gcl[i]);
            }
#pragma unroll
            for (int i = 1; i < 64; ++i) {
                float r = x[i];
#pragma unroll
                for (int j4 = 0; j4 <= (i - 1) / 4; ++j4) { const f32x4 a4 = *(const LAS f32x4*)(Al + i * 64 + 4 * j4);
                    r -= a4.x * x[4 * j4]; if (4 * j4 + 1 < i) r -= a4.y * x[4 * j4 + 1]; if (4 * j4 + 2 < i) r -= a4.z * x[4 * j4 + 2]; if (4 * j4 + 3 < i) r -= a4.w * x[4 * j4 + 3]; }
                x[i] = r;
            }
            if (t4 < 128) {
                const int sl = t4 >> 4, col = t4 & 15;
#pragma unroll
                for (int rt = 0; rt < 4; ++rt) { unsigned char* Ub = ((rt >> 1) == 0 ? U0 : U1) + (size_t)unit * DU_UNIT;
#pragma unroll
                    for (int qd = 0; qd < 4; ++qd) { const int i0 = 16 * rt + 4 * qd; u32x2 w; w.x = pk2(x[i0], x[i0 + 1]); w.y = pk2(x[i0 + 2], x[i0 + 3]);
                        *(u32x2*)(Ub + (((sl * 2 + (rt & 1)) * 64 + qd * 16 + col) * 8)) = w; } }
            } else {
                const int dd = t4 - 128;
#pragma unroll
                for (int i = 0; i < 64; ++i) *(LAS unsigned short*)(NWl + i * 272 + dd * 2) = (unsigned short)f2bf(-x[i]);
            }
        }
        {
            const float gl = gcl[63];
#pragma unroll
            for (int k = 0; k < 4; ++k) {
                const int it = t4 + 256 * k, f = it >> 6, ln = it & 63, rt = f >> 2, ks = f & 3, i = 16 * rt + (ln & 15), qd = ln >> 4;
                const bf16* src = QK + (m0 + i) * 1024 + h * 128 + 32 * ks + 4 * qd; const float e = __expf(gcl[i]);
                const u32x2 a = *(const u32x2*)src, c2 = *(const u32x2*)(src + 16);
                u32x4 w; w.x = pk2(bflo(a.x) * e, bfhi(a.x) * e); w.y = pk2(bflo(a.y) * e, bfhi(a.y) * e); w.z = pk2(bflo(c2.x) * e, bfhi(c2.x) * e); w.w = pk2(bflo(c2.y) * e, bfhi(c2.y) * e);
                *(u32x4*)(FRu + DFR_QD + (size_t)it * 16) = w;
            }
#pragma unroll
            for (int k = 0; k < 4; ++k) {
                const int it = t4 + 256 * k, f = it >> 6, ln = it & 63, rt = f >> 1, ks = f & 1, dk = 16 * rt + (ln & 15), qd = ln >> 4;
                const bf16* src = QK + (m0 + 32 * ks + 4 * qd) * 1024 + 512 + h * 128 + dk;
                float v[8];
#pragma unroll
                for (int jj = 0; jj < 8; ++jj) { const int ioff = 16 * (jj >> 2) + (jj & 3); v[jj] = bf2f(src[(size_t)ioff * 1024]) * __expf(gl - gcl[32 * ks + 4 * qd + ioff]); }
                u32x4 w; w.x = pk2(v[0], v[1]); w.y = pk2(v[2], v[3]); w.z = pk2(v[4], v[5]); w.w = pk2(v[6], v[7]);
                *(u32x4*)(FRu + DFR_KST + (size_t)it * 16) = w;
            }
        }
        __syncthreads();
        {
#pragma unroll
            for (int k = 0; k < 4; ++k) {
                const int it = t4 + 256 * k, f = it >> 6, ln = it & 63, rt = f >> 2, ks = f & 3, i = 16 * rt + (ln & 15), qd = ln >> 4;
                const LAS unsigned char* s = NWl + i * 272 + (32 * ks + 4 * qd) * 2;
                const u32x2 a = *(const LAS u32x2*)s, c2 = *(const LAS u32x2*)(s + 32);
                u32x4 w; w.x = a.x; w.y = a.y; w.z = c2.x; w.w = c2.y;
                *(u32x4*)(FRu + DFR_NW + (size_t)it * 16) = w;
            }
#pragma unroll
            for (int k = 0; k < 2; ++k) {
                const int it = t4 + 256 * k, f = it >> 6, ln = it & 63, rt = f >> 1, ks = f & 1, i = 16 * rt + (ln & 15), qd = ln >> 4;
                const LAS unsigned char* s = ATl + i * 144 + (32 * ks + 4 * qd) * 2;
                const u32x2 a = *(const LAS u32x2*)s, c2 = *(const LAS u32x2*)(s + 32);
                u32x4 w; w.x = a.x; w.y = a.y; w.z = c2.x; w.w = c2.y;
                *(u32x4*)(FRu + DFR_ATT + (size_t)it * 16) = w;
            }
        }
        __syncthreads();
    }
}
typedef float f32x4v __attribute__((ext_vector_type(4)));
#define MFMA16(a, b, c) __builtin_amdgcn_mfma_f32_16x16x32_bf16((a), (b), (c), 0, 0, 0)
__device__ __forceinline__ u32x4 packB16(const f32x4v& t0, const f32x4v& t1) {
    u32x4 w; w.x = cvtpk(t0[0], t0[1]); w.y = cvtpk(t0[2], t0[3]); w.z = cvtpk(t1[0], t1[1]); w.w = cvtpk(t1[2], t1[3]);
    return w;
}
__device__ __forceinline__ void delta_scan_phase(const unsigned char* FR, const unsigned char* U0, const unsigned char* U1, const float* GL, float* OB,
                                                 LAS unsigned char* lds, int bid, int tid, int lane, int wave) {
    if (bid >= 64) return;
    const int bh = bid & 7, b = bh >> 2, h = bh & 3, col = lane & 15, qd = lane >> 4;
    const int lt = tid - 128, sl = bid >> 3;
    const unsigned char* FRb = FR + (size_t)bh * 128 * DFR_UNIT;
    LAS u32x4* xs = (LAS u32x4*)(lds + 2 * DFR_UNIT) + lane;
    LAS u32x4* xv = (LAS u32x4*)(lds + 2 * DFR_UNIT + 4096) + lane;
#define LD_ISSUE(R, step) do { if ((step) < 128) { const u32x4* g_ = (const u32x4*)(FRb + (size_t)(step) * DFR_UNIT) + lt; \
        _Pragma("unroll") for (int k = 0; k < 9; ++k) R[k] = g_[384 * k]; if (lt < 128) R[9] = g_[384 * 9]; } } while (0)
#define LD_WRITE(R, buf) do { LAS u32x4* d_ = (LAS u32x4*)(lds + (buf) * DFR_UNIT) + lt; \
        _Pragma("unroll") for (int k = 0; k < 9; ++k) d_[384 * k] = R[k]; if (lt < 128) d_[384 * 9] = R[9]; } while (0)
#define LSTEP(c, R) do { LD_WRITE(R, ((c) + 1) & 1); LD_ISSUE(R, (c) + 5); LDS_BARRIER(); LDS_BARRIER(); } while (0)
#define DFRAG_A(g, j) ((g) < 4 ? (DFR_NW / 16) + ((j) * 4 + (g)) * 64 : (DFR_KST / 16) + ((4 * (((g) - 4) & 1) + (j)) * 2 + (((g) - 4) >> 1)) * 64)
#define DFRAG_B(g, j) ((g) < 4 ? (DFR_QD / 16) + ((j) * 4 + (g)) * 64 : (DFR_ATT / 16) + ((j) * 2 + ((g) - 4)) * 64)
    if (wave >= 2) {
        u32x4 R0[10], R1[10], R2[10], R3[10];
        LD_ISSUE(R0, 0); LD_WRITE(R0, 0); LD_ISSUE(R1, 1); LD_ISSUE(R2, 2); LD_ISSUE(R3, 3); LD_ISSUE(R0, 4);
        LDS_BARRIER();
        for (int c = 0; c < 128; c += 4) { LSTEP(c, R1); LSTEP(c + 1, R2); LSTEP(c + 2, R3); LSTEP(c + 3, R0); }
    } else if (wave == 0) {
        f32x4v S[8];
#pragma unroll
        for (int r = 0; r < 8; ++r) S[r] = (f32x4v){0.f, 0.f, 0.f, 0.f};
        u32x4 sp[4];
#pragma unroll
        for (int ks = 0; ks < 4; ++ks) { sp[ks] = (u32x4){0u, 0u, 0u, 0u}; xs[ks * 64] = sp[ks]; }
        u32x2 ucur[4]; float glc;
#pragma unroll
        for (int rt = 0; rt < 4; ++rt) ucur[rt] = *((const u32x2*)(((rt >> 1) == 0 ? U0 : U1) + (size_t)(bh * 128) * DU_UNIT) + (sl * 2 + (rt & 1)) * 64 + lane);
        glc = GL[bh * 128];
        LDS_BARRIER();
        for (int c = 0; c < 128; ++c) {
            const int unit = bh * 128 + c;
            const LAS u32x4* fr = (const LAS u32x4*)(lds + (c & 1) * DFR_UNIT) + lane;
            u32x4 fg[4][4];
#pragma unroll
            for (int j = 0; j < 4; ++j) { fg[0][j] = fr[DFRAG_A(0, j)]; fg[1][j] = fr[DFRAG_A(1, j)]; fg[2][j] = fr[DFRAG_A(2, j)]; }
            f32x4v vn[4];
#pragma unroll
            for (int rt = 0; rt < 4; ++rt) { const u32x2 w = ucur[rt]; vn[rt][0] = bflo(w.x); vn[rt][1] = bfhi(w.x); vn[rt][2] = bflo(w.y); vn[rt][3] = bfhi(w.y); }
            float gln = glc;
            if (c + 1 < 128) {
#pragma unroll
                for (int rt = 0; rt < 4; ++rt) ucur[rt] = *((const u32x2*)(((rt >> 1) == 0 ? U0 : U1) + (size_t)(unit + 1) * DU_UNIT) + (sl * 2 + (rt & 1)) * 64 + lane);
                gln = GL[unit + 1];
            }
            u32x4 vp0, vp1;
#pragma unroll
            for (int g = 0; g < 8; ++g) {
                if (g + 3 < 8) {
#pragma unroll
                    for (int j = 0; j < 4; ++j) fg[(g + 3) & 3][j] = fr[DFRAG_A(g + 3, j)];
                }
                asm volatile("" ::: "memory");
                const bf16x8_t f0 = __builtin_bit_cast(bf16x8_t, fg[g & 3][0]), f1 = __builtin_bit_cast(bf16x8_t, fg[g & 3][1]), f2 = __builtin_bit_cast(bf16x8_t, fg[g & 3][2]), f3 = __builtin_bit_cast(bf16x8_t, fg[g & 3][3]);
                if (g < 4) { const bf16x8_t s = __builtin_bit_cast(bf16x8_t, sp[g]);
                    vn[0] = MFMA16(f0, s, vn[0]); vn[1] = MFMA16(f1, s, vn[1]); vn[2] = MFMA16(f2, s, vn[2]); vn[3] = MFMA16(f3, s, vn[3]);
                    if (g == 3) { vp0 = packB16(vn[0], vn[1]); vp1 = packB16(vn[2], vn[3]); xv[0] = vp0; xv[64] = vp1;
                        LDS_BARRIER();
#pragma unroll
                        for (int r = 0; r < 8; ++r) S[r] *= glc; } }
                else { const int q4 = g - 4, r0 = 4 * (q4 & 1); const bf16x8_t v = __builtin_bit_cast(bf16x8_t, (q4 >> 1) == 0 ? vp0 : vp1);
                    S[r0] = MFMA16(f0, v, S[r0]); S[r0 + 1] = MFMA16(f1, v, S[r0 + 1]); S[r0 + 2] = MFMA16(f2, v, S[r0 + 2]); S[r0 + 3] = MFMA16(f3, v, S[r0 + 3]); }
            }
#pragma unroll
            for (int ks = 0; ks < 4; ++ks) { sp[ks] = packB16(S[2 * ks], S[2 * ks + 1]); xs[ks * 64] = sp[ks]; }
            glc = gln;
            LDS_BARRIER();
        }
    } else {
        LDS_BARRIER();
        for (int c = 0; c < 128; ++c) {
            const LAS u32x4* fr = (const LAS u32x4*)(lds + (c & 1) * DFR_UNIT) + lane;
            u32x4 fg[4][4];
#pragma unroll
            for (int j = 0; j < 4; ++j) { fg[0][j] = fr[DFRAG_B(0, j)]; fg[1][j] = fr[DFRAG_B(1, j)]; fg[2][j] = fr[DFRAG_B(2, j)]; }
            u32x4 spb[4];
#pragma unroll
            for (int ks = 0; ks < 4; ++ks) spb[ks] = xs[ks * 64];
            f32x4v o[4];
#pragma unroll
            for (int rt = 0; rt < 4; ++rt) o[rt] = (f32x4v){0.f, 0.f, 0.f, 0.f};
            u32x4 vp0, vp1;
#pragma unroll
            for (int g = 0; g < 6; ++g) {
                if (g + 3 < 6) {
#pragma unroll
                    for (int j = 0; j < 4; ++j) fg[(g + 3) & 3][j] = fr[DFRAG_B(g + 3, j)];
                }
                asm volatile("" ::: "memory");
                if (g == 4) { LDS_BARRIER(); vp0 = xv[0]; vp1 = xv[64]; }
                const bf16x8_t f0 = __builtin_bit_cast(bf16x8_t, fg[g & 3][0]), f1 = __builtin_bit_cast(bf16x8_t, fg[g & 3][1]), f2 = __builtin_bit_cast(bf16x8_t, fg[g & 3][2]), f3 = __builtin_bit_cast(bf16x8_t, fg[g & 3][3]);
                const bf16x8_t bop = __builtin_bit_cast(bf16x8_t, g < 4 ? spb[g < 4 ? g : 0] : (g == 4 ? vp0 : vp1));
                o[0] = MFMA16(f0, bop, o[0]); o[1] = MFMA16(f1, bop, o[1]); o[2] = MFMA16(f2, bop, o[2]); o[3] = MFMA16(f3, bop, o[3]);
            }
            { float* ob = OB + ((size_t)b * SEQ + c * 64) * 512 + h * 128 + 16 * sl + col;
#pragma unroll
              for (int rt = 0; rt < 4; ++rt)
#pragma unroll
                  for (int j = 0; j < 4; ++j) ob[(size_t)(16 * rt + 4 * qd + j) * 512] = o[rt][j]; }
            LDS_BARRIER();
        }
    }
#undef DFRAG_A
#undef DFRAG_B
#undef LSTEP
#undef LD_ISSUE
#undef LD_WRITE
}

__device__ __forceinline__ void delta_pre_phase(const bf16* PROJ, const float* convw, bf16* QK, bf16* VB, int gw, int NGW, int lane) {
    for (int it = gw; it < (MROWS / 8) * 3; it += NGW) {
        const int blk = it / 3, s = it - blk * 3, t0 = (blk * 8) & (SEQ - 1);
        const size_t m0 = (size_t)blk * 8;
        const bf16* src = PROJ + m0 * NP0 + 1536 + s * 512 + 8 * lane;
        u32x4 xr[11];
#pragma unroll
        for (int r = 0; r < 11; ++r) { if (t0 + r - 3 >= 0) xr[r] = *(const u32x4*)(src + (ptrdiff_t)(r - 3) * NP0); else xr[r] = (u32x4){0u, 0u, 0u, 0u}; }
        float w[4][8];
#pragma unroll
        for (int j = 0; j < 4; ++j) { const f32x4 a = *(const f32x4*)(convw + j * 1536 + s * 512 + 8 * lane), c = *(const f32x4*)(convw + j * 1536 + s * 512 + 8 * lane + 4);
            w[j][0] = a.x; w[j][1] = a.y; w[j][2] = a.z; w[j][3] = a.w; w[j][4] = c.x; w[j][5] = c.y; w[j][6] = c.z; w[j][7] = c.w; }
#pragma unroll
        for (int r = 0; r < 8; ++r) {
            float acc[8], f[8];
#pragma unroll
            for (int i = 0; i < 8; ++i) acc[i] = 0.f;
#pragma unroll
            for (int j = 0; j < 4; ++j) { unpack8(xr[r + j], f);
#pragma unroll
                for (int i = 0; i < 8; ++i) acc[i] += w[j][i] * f[i]; }
            float ss = 0.f;
#pragma unroll
            for (int i = 0; i < 8; ++i) { acc[i] = silu_f(acc[i]); ss += acc[i] * acc[i]; }
            float sc = 1.f;
            if (s < 2) { ss += __shfl_xor(ss, 1); ss += __shfl_xor(ss, 2); ss += __shfl_xor(ss, 4); ss += __shfl_xor(ss, 8); sc = rsqrtf(ss + 1e-6f) * (s == 0 ? 0.08838834764831845f : 1.f); }
            u32x4 o; o.x = pk2(acc[0] * sc, acc[1] * sc); o.y = pk2(acc[2] * sc, acc[3] * sc); o.z = pk2(acc[4] * sc, acc[5] * sc); o.w = pk2(acc[6] * sc, acc[7] * sc);
            if (s < 2) *(u32x4*)(QK + (m0 + r) * 1024 + s * 512 + 8 * lane) = o; else *(u32x4*)(VB + (m0 + r) * 512 + 8 * lane) = o;
        }
    }
}
__device__ __forceinline__ void delta_post_phase(const float* OB, const bf16* PROJ, const float* nw, bf16* MIX, int gw, int NGW, int lane) {
    const int e0 = (8 * lane) & 127;
    const f32x4 w0 = *(const f32x4*)(nw + e0), w1 = *(const f32x4*)(nw + e0 + 4);
    for (int mb = gw; mb < MROWS; mb += 4 * NGW) {
        f32x4 a[4], c[4]; u32x4 z[4];
#pragma unroll
        for (int k = 0; k < 4; ++k) { const size_t m = (size_t)mb + (size_t)k * NGW; if (m < MROWS) { a[k] = *(const f32x4*)(OB + m * 512 + 8 * lane); c[k] = *(const f32x4*)(OB + m * 512 + 8 * lane + 4); z[k] = *(const u32x4*)(PROJ + m * NP0 + 3072 + 8 * lane); } }
#pragma unroll
        for (int k = 0; k < 4; ++k) { const size_t m = (size_t)mb + (size_t)k * NGW; if (m < MROWS) {
            float ss = (a[k].x * a[k].x + a[k].y * a[k].y) + (a[k].z * a[k].z + a[k].w * a[k].w) + (c[k].x * c[k].x + c[k].y * c[k].y) + (c[k].z * c[k].z + c[k].w * c[k].w);
            ss += __shfl_xor(ss, 1); ss += __shfl_xor(ss, 2); ss += __shfl_xor(ss, 4); ss += __shfl_xor(ss, 8);
            const float rs = rsqrtf(ss * (1.f / 128.f) + 1e-6f);
            u32x4 o; o.x = pk2(a[k].x * rs * w0.x * silu_f(bflo(z[k].x)), a[k].y * rs * w0.y * silu_f(bfhi(z[k].x))); o.y = pk2(a[k].z * rs * w0.z * silu_f(bflo(z[k].y)), a[k].w * rs * w0.w * silu_f(bfhi(z[k].y)));
            o.z = pk2(c[k].x * rs * w1.x * silu_f(bflo(z[k].z)), c[k].y * rs * w1.y * silu_f(bfhi(z[k].z))); o.w = pk2(c[k].z * rs * w1.z * silu_f(bflo(z[k].w)), c[k].w * rs * w1.w * silu_f(bfhi(z[k].w)));
            *(u32x4*)(MIX + m * 1024 + 512 + 8 * lane) = o; } }
    }
}
__device__ __forceinline__ void fcum_phase(float* GATES, int gw, int lane) {
    if (gw >= 16) return;
    const int b = gw >> 3, h = gw & 7;
    float* base = GATES + ((size_t)b * SEQ + (size_t)lane * 128) * 16 + 8 + h;
    float tot = 0.f;
#pragma unroll 16
    for (int i = 0; i < 128; ++i) tot += base[(size_t)i * 16];
    float incl = tot;
#pragma unroll
    for (int o = 1; o < 64; o <<= 1) { const float tt = __shfl_up(incl, o); if (lane >= o) incl += tt; }
    float run = incl - tot;
    for (int i0 = 0; i0 < 128; i0 += 16) {
        float v[16];
#pragma unroll
        for (int j = 0; j < 16; ++j) v[j] = base[(size_t)(i0 + j) * 16];
#pragma unroll
        for (int j = 0; j < 16; ++j) { run += v[j]; base[(size_t)(i0 + j) * 16] = run; }
    }
}
__global__ void __launch_bounds__(NTHR, 2) mega_fwd(Params p) {
    extern __shared__ __attribute__((aligned(16))) unsigned char lds_raw[];
    cg::grid_group grid = cg::this_grid();
    LAS unsigned char* lds = (LAS unsigned char*)lds_raw;
    const int wave = __builtin_amdgcn_readfirstlane(threadIdx.x >> 6);
    int lane, tid;
#define REMAT_IDS() do { asm volatile("v_mbcnt_lo_u32_b32 %0, -1, 0\n\tv_mbcnt_hi_u32_b32 %0, -1, %0" : "=v"(lane)); tid = wave * 64 + lane; } while (0)
    REMAT_IDS();
    volatile LAS unsigned* bst = (volatile LAS unsigned*)(lds + 147392);
    if (threadIdx.x < 2) bst[threadIdx.x] = 0u;
    __syncthreads();
    XcdBarrier xbar = xcd_barrier_post((unsigned*)p.ws, bst);
#define GSYNC() do { xcd_barrier(xbar); REMAT_IDS(); } while (0)
    const int G = gridDim.x, bid = blockIdx.x;
    const int gw = bid * NWAVES + wave, NGW = G * NWAVES;
    unsigned char* ws = p.ws;
    bf16* XN = (bf16*)(ws + WS_XN); bf16* MIX = (bf16*)(ws + WS_MIX); bf16* PROJ = (bf16*)(ws + WS_PROJ); float* GATES = (float*)(ws + WS_GATES);
    bf16* VB = (bf16*)(ws + WS_SPARE); bf16* XBC = (bf16*)(ws + WS_XBC);
    float* OUT = p.out;

    weights_phase(p, lds, gw, NGW, wave, lane, 3);
    __syncthreads();
    rows_phase<1>(p.in[0], p.in[1], XN, p.in[7], p.in[10], p.in[11], GATES, lds, gw, NGW, tid, lane);
    grid.sync(); REMAT_IDS();
    { pg8::Gemm g{XN, (const bf16*)(ws + WS_WIN0), MROWS, NP0, DM}; pg8::StaticOrder S; S.init(MROWS, NP0, G, bid);
      pg8::EpiBf16<0> E{PROJ, NP0, nullptr, 0, 0, 1.f};
      pg8::gemm_phase<pg8::EpiBf16<0>, pg8::StaticOrder, true, true>(lds, g, S, E); }
    if (bid >= G / 2) weights_phase(p, lds, (bid - G / 2) * NWAVES + wave, (G - G / 2) * NWAVES, wave, lane, 5);
    GSYNC();
    delta_pre_phase(PROJ, p.in[9], XN  , VB, gw, NGW, lane);
    GSYNC();
    delta_prep_phase(XN  , VB, GATES, (unsigned char*)OUT  , (unsigned char*)OUT + 56 * MiB  , ws + WS_SPARE + 16 * MiB  , (float*)(ws + WS_SPARE + 24 * MiB)  , lds, bid, G, tid, lane, wave);
    GSYNC();
    delta_scan_phase((const unsigned char*)OUT, (const unsigned char*)OUT + 56 * MiB, ws + WS_SPARE + 16 * MiB, (const float*)(ws + WS_SPARE + 24 * MiB), (float*)XN  , lds, bid, tid, lane, wave);
    band_fast_phase(PROJ, p.in[8], MIX, lds, bid, 64, G, tid, lane, wave);
    if (bid >= 64) weights_phase(p, lds, (bid - 64) * NWAVES + wave, (G - 64) * NWAVES, wave, lane, 6);
    GSYNC();
    delta_post_phase((const float*)XN, PROJ, p.in[12], MIX, gw, NGW, lane);
    GSYNC();
    { pg8::Gemm g{MIX, (const bf16*)(ws + WS_WOUT0), MROWS, DM, DM}; pg8::StaticOrder S; S.init(MROWS, DM, G, bid);
      pg8::EpiResRms<0> E{p.in[0], OUT, XN, DM, p.in[2], (float*)(ws + 254 * MiB), (unsigned*)(ws + 65536)};
      pg8::gemm_phase<pg8::EpiResRms<0>, pg8::StaticOrder, false, true>(lds, g, S, E); }
    GSYNC();
    { pg8::Gemm g{XN, (const bf16*)(ws + WS_WGU0), MROWS, 2 * FF, DM}; pg8::StaticOrder S; S.init(MROWS, 2 * FF, G, bid);
      pg8::EpiSwiglu E{PROJ  , FF};
      pg8::gemm_phase<pg8::EpiSwiglu, pg8::StaticOrder, true, true>(lds, g, S, E); }
    GSYNC();
    { pg8::Gemm g{PROJ  , (const bf16*)(ws + WS_WDN0), MROWS, DM, FF}; pg8::StaticOrder S; S.init(MROWS, DM, G, bid);
      pg8::EpiResF32 E{OUT, OUT, DM};
      pg8::gemm_phase<pg8::EpiResF32, pg8::StaticOrder, true, true>(lds, g, S, E); }
    GSYNC();
    rows_phase<2>(OUT, p.in[1] + DM, XN, p.in[14], p.in[17], p.in[21], GATES, lds, gw, NGW, tid, lane);
    GSYNC();
    { pg8::Gemm g{XN, (const bf16*)(ws + WS_WIN1), MROWS, NP1, DM}; pg8::StaticOrder S; S.init(MROWS, NP1, G, bid);
      pg8::EpiBf16<0> E{PROJ, NP1, nullptr, 0, 0, 1.f};
      pg8::gemm_phase<pg8::EpiBf16<0>, pg8::StaticOrder, true, true>(lds, g, S, E); }
    GSYNC();
    ssd_states_phase(PROJ, p.in[15], p.in[16], XBC, GATES, p.in[18], XN  , (float*)(ws + WS_SPARE + 16 * MiB), (unsigned*)(ws + 196608), lds, bid, G, tid, lane, wave);
    GSYNC();
    ssd_scan_phase(XN  , (const float*)(ws + WS_SPARE + 16 * MiB), bid, G, tid);
    if (bid >= G / 2) fcum_phase(GATES, (bid - G / 2) * NWAVES + wave, lane);
    GSYNC();
    ssd_out_phase(XBC, PROJ, GATES, p.in[18], p.in[19], p.in[20], XN  , MIX, lds, bid, G, tid, lane, wave);
    fox_acp_phase(PROJ, GATES, (const unsigned*)(ws + 196608), MIX, lds, bid, G, tid, lane, wave);
    GSYNC();
    { pg8::Gemm g{MIX, (const bf16*)(ws + WS_WOUT1), MROWS, DM, DM}; pg8::StaticOrder S; S.init(MROWS, DM, G, bid);
      pg8::EpiResRms<0> E{OUT, OUT, XN, DM, p.in[2] + DM, (float*)(ws + 254 * MiB), (unsigned*)(ws + 65536 + 16384)};
      pg8::gemm_phase<pg8::EpiResRms<0>, pg8::StaticOrder, false, true>(lds, g, S, E); }
    GSYNC();
    { pg8::Gemm g{XN, (const bf16*)(ws + WS_WGU1), MROWS, 2 * FF, DM}; pg8::StaticOrder S; S.init(MROWS, 2 * FF, G, bid);
      pg8::EpiSwiglu E{PROJ  , FF};
      pg8::gemm_phase<pg8::EpiSwiglu, pg8::StaticOrder, true, true>(lds, g, S, E); }
    GSYNC();
    { pg8::Gemm g{PROJ  , (const bf16*)(ws + WS_WDN1), MROWS, DM, FF}; pg8::StaticOrder S; S.init(MROWS, DM, G, bid);
      pg8::EpiResRms<1> E{OUT, OUT, nullptr, DM, p.in[3], (float*)(ws + 254 * MiB), (unsigned*)(ws + 65536 + 32768)};
      pg8::gemm_phase<pg8::EpiResRms<1>, pg8::StaticOrder, false, true>(lds, g, S, E); }
}

extern "C" void kernel_launch(void* const* d_in, const int* in_sizes, int n_in, void* d_out, int out_size, void* d_ws, size_t ws_size, hipStream_t stream) {
    static int grid = 0;
    if (grid == 0) {
        int dev = 0, cus = 0, per_cu = 0;
        hipGetDevice(&dev);
        hipDeviceGetAttribute(&cus, hipDeviceAttributeMultiprocessorCount, dev);
        if (hipFuncSetAttribute((const void*)mega_fwd, hipFuncAttributeMaxDynamicSharedMemorySize, LDS_BYTES) != hipSuccess) { fprintf(stderr, "hipFuncSetAttribute failed\n"); }
        if (hipOccupancyMaxActiveBlocksPerMultiprocessor(&per_cu, (const void*)mega_fwd, NTHR, LDS_BYTES) != hipSuccess || per_cu < 1) { fprintf(stderr, "occupancy query: %d\n", per_cu); per_cu = 1; }
        (void)hipGetLastError();
        grid = cus * 1;
        if (grid <= 0) grid = 256;
    }
    Params p{};
    for (int i = 0; i < 23; ++i) p.in[i] = (const float*)d_in[i];
    p.out = (float*)d_out; p.ws = (unsigned char*)d_ws;
    (void)hipMemsetAsync(d_ws, 0, 262144, stream);
    void* args[] = {&p};
    hipError_t e = hipLaunchCooperativeKernel((const void*)mega_fwd, dim3(grid), dim3(NTHR), args, LDS_BYTES, stream);
    if (e != hipSuccess) fprintf(stderr, "cooperative launch failed: %s (grid %d)\n", hipGetErrorString(e), grid);
}
```
